# Optimizing an MI355X kernel written in HIP

```python
import jax, jax.numpy as jnp
from jax import lax
import numpy as np

D_MODEL = 1024
BATCH = 16
SEQ = 2048
DEPTH = 2

N_MIXERS = 2
N_MLA_LAYERS = (DEPTH + 1) // 2
N_FOX_LAYERS = DEPTH // 2

MLA_HEADS = 8
MLA_NOPE_DIM = 128
MLA_ROPE_DIM = 64
MLA_V_DIM = 128
MLA_Q_RANK = 256
MLA_KV_RANK = 256
ROPE_THETA = 10000.0

FOX_HEADS = 16
FOX_HEAD_DIM = D_MODEL // FOX_HEADS

D_FF = -(-8 * D_MODEL // (3 * 256)) * 256

Q_BLOCK = 128
DEEPNORM_ALPHA = (2.0 * DEPTH) ** 0.25
DEEPNORM_BETA = (8.0 * DEPTH) ** -0.25
NORM_EPS = 1e-5
MLA_IN_DIM = MLA_Q_RANK + MLA_KV_RANK + MLA_ROPE_DIM
FOX_IN_DIM = 3 * D_MODEL + FOX_HEADS

kernel_name = "hybrid_mla_fox_deepnorm_adaln"


def rms_norm(x, g):
    xf = x.astype(jnp.float32)
    y = xf * lax.rsqrt(jnp.mean(xf * xf, axis=-1, keepdims=True) + NORM_EPS)
    return (y * g.astype(jnp.float32)).astype(x.dtype)


def layer_norm(x, g, b):
    xf = x.astype(jnp.float32)
    mu = jnp.mean(xf, axis=-1, keepdims=True)
    var = jnp.mean(jnp.square(xf - mu), axis=-1, keepdims=True)
    y = (xf - mu) * lax.rsqrt(var + NORM_EPS)
    return (y * g.astype(jnp.float32) + b.astype(jnp.float32)).astype(x.dtype)


def rotary_angles(positions, dim):
    half = dim // 2
    inv_freq = ROPE_THETA ** (-jnp.arange(half, dtype=jnp.float32) / half)
    ang = positions.astype(jnp.float32)[..., None] * inv_freq
    return jnp.cos(ang), jnp.sin(ang)


def apply_rotary(x, cos, sin):
    half = x.shape[-1] // 2
    x1, x2 = x[..., :half], x[..., half:]
    cos = cos.astype(x.dtype)
    sin = sin.astype(x.dtype)
    return jnp.concatenate([x1 * cos - x2 * sin, x2 * cos + x1 * sin], axis=-1)


def causal_block_attention(logits_fn, v):
    b, h, s, dv = v.shape
    key_pos = jnp.arange(s)

    def one_block(blk):
        q_start = blk * Q_BLOCK
        logits = logits_fn(q_start)
        q_pos = q_start + jnp.arange(Q_BLOCK)
        causal = q_pos[:, None] >= key_pos[None, :]
        probs = jax.nn.softmax(jnp.where(causal, logits, -jnp.inf), axis=-1)
        return jnp.einsum('bhqs,bhsd->bhqd', probs.astype(v.dtype), v)

    out = lax.map(one_block, jnp.arange(s // Q_BLOCK))
    return out.transpose(1, 0, 3, 2, 4).reshape(b, s, h * dv)


def mla_mixer(u, cos, sin, w_in, g_q, w_uq, g_kv, w_uk, w_uv, w_o):
    b, s, _ = u.shape
    h_in = u @ w_in
    c_q = rms_norm(h_in[..., :MLA_Q_RANK], g_q)
    c_kv = rms_norm(h_in[..., MLA_Q_RANK:MLA_Q_RANK + MLA_KV_RANK], g_kv)
    k_rope = apply_rotary(h_in[..., MLA_Q_RANK + MLA_KV_RANK:], cos, sin)

    q = (c_q @ w_uq).reshape(b, s, MLA_HEADS, MLA_NOPE_DIM + MLA_ROPE_DIM)
    q_nope = q[..., :MLA_NOPE_DIM].transpose(0, 2, 1, 3)
    q_rope = apply_rotary(q[..., MLA_NOPE_DIM:], cos[:, :, None, :], sin[:, :, None, :])
    q_rope = q_rope.transpose(0, 2, 1, 3)
    k_nope = (c_kv @ w_uk).reshape(b, s, MLA_HEADS, MLA_NOPE_DIM).transpose(0, 2, 1, 3)
    v = (c_kv @ w_uv).reshape(b, s, MLA_HEADS, MLA_V_DIM).transpose(0, 2, 1, 3)
    scale = (MLA_NOPE_DIM + MLA_ROPE_DIM) ** -0.5

    def logits_fn(q_start):
        qn = lax.dynamic_slice_in_dim(q_nope, q_start, Q_BLOCK, axis=2)
        qr = lax.dynamic_slice_in_dim(q_rope, q_start, Q_BLOCK, axis=2)
        sc = (jnp.einsum('bhqd,bhsd->bhqs', qn, k_nope)
              + jnp.einsum('bhqr,bsr->bhqs', qr, k_rope))
        return sc.astype(jnp.float32) * scale

    return causal_block_attention(logits_fn, v) @ w_o


def fox_mixer(u, w_in, b_f, w_o):
    b, s, d = u.shape
    h_in = u @ w_in
    def heads(t):
        return t.reshape(b, s, FOX_HEADS, FOX_HEAD_DIM).transpose(0, 2, 1, 3)
    q = heads(h_in[..., :d])
    k = heads(h_in[..., d:2 * d])
    v = heads(h_in[..., 2 * d:3 * d])
    log_f = jax.nn.log_sigmoid(h_in[..., 3 * d:].astype(jnp.float32) + b_f.astype(jnp.float32))
    cum_log_f = lax.cumsum(log_f, axis=1).transpose(0, 2, 1)
    scale = FOX_HEAD_DIM ** -0.5

    def logits_fn(q_start):
        qb = lax.dynamic_slice_in_dim(q, q_start, Q_BLOCK, axis=2)
        fq = lax.dynamic_slice_in_dim(cum_log_f, q_start, Q_BLOCK, axis=2)
        sc = jnp.einsum('bhqd,bhsd->bhqs', qb, k).astype(jnp.float32) * scale
        return sc + fq[..., :, None] - cum_log_f[:, :, None, :]

    return causal_block_attention(logits_fn, v) @ w_o


def swiglu(u, w_gate, w_up, w_down):
    return (jax.nn.silu(u @ w_gate) * (u @ w_up)) @ w_down


def modulate(x, shift, scale):
    return x * (1.0 + scale[:, None, :]) + shift[:, None, :]


def setup_inputs(seed: int = 0) -> dict:
    key = jax.random.key(seed)
    ks = iter(jax.random.split(key, 40))
    f32 = jnp.float32
    def nrm(shape, std):
        return jax.random.normal(next(ks), shape, f32) * std
    D, H, Hf = D_MODEL, MLA_HEADS, FOX_HEADS
    beta = DEEPNORM_BETA
    nm, nf = N_MLA_LAYERS, N_FOX_LAYERS

    x = jax.random.normal(next(ks), (BATCH, SEQ, D), f32)
    c = jax.random.normal(next(ks), (BATCH, D), f32)
    positions = (jnp.arange(SEQ, dtype=jnp.int32)[None, :]
                 + jax.random.randint(next(ks), (BATCH, 1), 0, 128, dtype=jnp.int32))

    mla_w_in = nrm((nm, D, MLA_IN_DIM), D ** -0.5)
    mla_g_q = 1.0 + nrm((nm, MLA_Q_RANK), 0.02)
    mla_w_uq = nrm((nm, MLA_Q_RANK, H * (MLA_NOPE_DIM + MLA_ROPE_DIM)), MLA_Q_RANK ** -0.5)
    mla_g_kv = 1.0 + nrm((nm, MLA_KV_RANK), 0.02)
    mla_w_uk = nrm((nm, MLA_KV_RANK, H * MLA_NOPE_DIM), MLA_KV_RANK ** -0.5)
    mla_w_uv = nrm((nm, MLA_KV_RANK, H * MLA_V_DIM), beta * MLA_KV_RANK ** -0.5)
    mla_w_o = nrm((nm, H * MLA_V_DIM, D), beta * (H * MLA_V_DIM) ** -0.5)

    fox_w_in = jnp.concatenate([
        nrm((nf, D, 2 * D), D ** -0.5),
        nrm((nf, D, D), beta * D ** -0.5),
        nrm((nf, D, Hf), D ** -0.5),
    ], axis=-1)
    fox_b_f = 2.0 + nrm((nf, Hf), 0.5)
    fox_w_o = nrm((nf, D, D), beta * D ** -0.5)

    ada_w = nrm((DEPTH, D, 6 * D), 0.1 * D ** -0.5)
    ada_b = nrm((DEPTH, 6 * D), 0.02)

    ffn_w_gate = nrm((DEPTH, D, D_FF), beta * D ** -0.5)
    ffn_w_up = nrm((DEPTH, D, D_FF), beta * D ** -0.5)
    ffn_w_down = nrm((DEPTH, D_FF, D), beta * D_FF ** -0.5)

    ln_g = 1.0 + nrm((DEPTH, 2, D), 0.02)
    ln_b = nrm((DEPTH, 2, D), 0.02)

    return {"x": x, "c": c, "positions": positions,
            "mla_w_in": mla_w_in, "mla_g_q": mla_g_q, "mla_w_uq": mla_w_uq,
            "mla_g_kv": mla_g_kv, "mla_w_uk": mla_w_uk, "mla_w_uv": mla_w_uv, "mla_w_o": mla_w_o,
            "fox_w_in": fox_w_in, "fox_b_f": fox_b_f, "fox_w_o": fox_w_o,
            "ada_w": ada_w, "ada_b": ada_b,
            "ffn_w_gate": ffn_w_gate, "ffn_w_up": ffn_w_up, "ffn_w_down": ffn_w_down,
            "ln_g": ln_g, "ln_b": ln_b}


def reference(x, c, positions, mla_w_in, mla_g_q, mla_w_uq, mla_g_kv, mla_w_uk, mla_w_uv, mla_w_o,
              fox_w_in, fox_b_f, fox_w_o, ada_w, ada_b, ffn_w_gate, ffn_w_up, ffn_w_down,
              ln_g, ln_b):
    d = D_MODEL
    cos, sin = rotary_angles(positions, MLA_ROPE_DIM)
    c_act = jax.nn.silu(c)
    for i in range(DEPTH):
        mod = c_act @ ada_w[i] + ada_b[i]
        sh_a, sc_a, gt_a = mod[:, :d], mod[:, d:2 * d], mod[:, 2 * d:3 * d]
        sh_f, sc_f, gt_f = mod[:, 3 * d:4 * d], mod[:, 4 * d:5 * d], mod[:, 5 * d:]

        u = modulate(x, sh_a, sc_a)
        j = i // N_MIXERS
        if i % N_MIXERS == 0:
            y = mla_mixer(u, cos, sin, mla_w_in[j], mla_g_q[j], mla_w_uq[j], mla_g_kv[j],
                          mla_w_uk[j], mla_w_uv[j], mla_w_o[j])
        else:
            y = fox_mixer(u, fox_w_in[j], fox_b_f[j], fox_w_o[j])
        x = layer_norm(DEEPNORM_ALPHA * x + (1.0 + gt_a[:, None, :]) * y, ln_g[i, 0], ln_b[i, 0])

        u = modulate(x, sh_f, sc_f)
        y = swiglu(u, ffn_w_gate[i], ffn_w_up[i], ffn_w_down[i])
        x = layer_norm(DEEPNORM_ALPHA * x + (1.0 + gt_f[:, None, :]) * y, ln_g[i, 1], ln_b[i, 1])
    return x
```

```cpp
#include <hip/hip_runtime.h>
#include <hip/hip_cooperative_groups.h>
#include <cstdio>
#include <cstdint>
namespace cg = cooperative_groups;
__device__ __forceinline__ int tid_opaque() { int t = threadIdx.x; asm volatile("" : "+v"(t)); return t; }
namespace pg8 {
#define PG8_LAS __attribute__((address_space(3)))
typedef unsigned short bf16_t;
typedef short bf16x8 __attribute__((ext_vector_type(8)));
typedef float f32x4 __attribute__((ext_vector_type(4)));
typedef unsigned u32x4 __attribute__((ext_vector_type(4)));
constexpr int BM = 256, BK = 64, HALF = 128, HTB = HALF * BK * 2  , STAGE_BYTES = 8 * HTB, NXCD = 8, WGM = 8;

__host__ __device__ __forceinline__ int lds_byte(int r, int c) { const int st = (r >> 4) * 2 + (c >> 5), rr = r & 15, cc = c & 31, ob = rr * 64 + cc * 2; return st * 1024 + (ob ^ (((ob >> 9) & 1) << 5)); }
__host__ __device__ __forceinline__ void stage_rc(int b, int& R, int& C) { const int st = b / 1024, sb = b % 1024, swz = sb ^ (((sb >> 9) & 1) << 5); R = (st >> 1) * 16 + swz / 64; C = (st & 1) * 32 + (swz % 64) / 2; }
__host__ __device__ __forceinline__ int perm32(int rho) { const int n = rho >> 4, i = rho & 15; return 8 * (i >> 2) + 4 * n + (i & 3); }

struct Unit { int pm, pn; };
struct Gemm { const bf16_t* A; const bf16_t* Bt; int M, N, K; };

struct StaticOrder {
    int nM, nN, nwg, G, c;
    __host__ __device__ void init(int M, int N, int G_, int c_) { nM = M / BM; nN = N / BM; nwg = nM * nN; G = G_; c = c_; }
    __host__ __device__ bool next(int i, Unit& u) const {
        const long L = (long)i * G + c; if (L >= nwg) return false;
        int wgid = (int)L; { const int q = nwg / NXCD, r = nwg % NXCD, xcd = wgid % NXCD, off = wgid / NXCD; wgid = (xcd < r ? xcd * (q + 1) : r * (q + 1) + (xcd - r) * q) + off; }
        const int nig = WGM * nN, gid = wgid / nig, fm = gid * WGM, gsz = (nM - fm) < WGM ? (nM - fm) : WGM;
        u.pm = fm + ((wgid % nig) % gsz); u.pn = (wgid % nig) / gsz; return true;
    }
    __device__ __forceinline__ void a_ready(const Unit&) const {}
    __device__ __forceinline__ void done(const Unit&) const {}
};
template <class Epi, class Sched, bool ALIGN_EPI = false, bool SP2 = false>
__device__ __forceinline__ void gemm_phase(PG8_LAS unsigned char* lds, const Gemm g, const Sched& S, const Epi& E) {
    const int tid = tid_opaque(), wid = __builtin_amdgcn_readfirstlane(tid >> 6), lane = tid & 63, wr = wid >> 2, wc = wid & 3, fr = lane & 15, fq = lane >> 4;
    const int K = g.K, nt = K / BK;
    unsigned voffA[2], voffB[2];
#pragma unroll
    for (int i = 0; i < 2; ++i) { int R, C; stage_rc(tid * 16 + i * 8192, R, C); const int Rb = Epi::PERM ? ((R & ~31) + perm32(R & 31)) : R;
        voffA[i] = (unsigned)(R * K + C) * 2u; voffB[i] = (unsigned)(Rb * K + C) * 2u; }
    const size_t kstep = (size_t)(BK * 2);
    const size_t hstep = (size_t)HALF * K * 2;
    const size_t tstep = 2 * hstep;
    const unsigned ldsw = (unsigned)wid * 1024u;
    const int aoff = lds_byte(wr * 64 + fr, fq * 8), boff = lds_byte(wc * 32 + fr, fq * 8);
#define PG8_SA(b, h) (((b) * 2 + (h)) * HTB)
#define PG8_SB(b, h) ((4 + (b) * 2 + (h)) * HTB)
#define PG8_STAGE(bufoff, gbase, voff) do { _Pragma("unroll") for (int _i = 0; _i < 2; ++_i) \
        __builtin_amdgcn_global_load_lds((const unsigned*)((const char*)(gbase) + (voff)[_i]), (PG8_LAS unsigned*)(lds + (bufoff) + ldsw + _i * 8192), 16, 0, 0); } while (0)
#define PG8_LDA(dst, b, h) do { _Pragma("unroll") for (int m = 0; m < 4; ++m) _Pragma("unroll") for (int k = 0; k < 2; ++k) dst[m][k] = *(const PG8_LAS bf16x8*)(lds + PG8_SA(b, h) + aoff + m * 2048 + k * 1024); } while (0)
#define PG8_LDB(dst, b, h) do { _Pragma("unroll") for (int n = 0; n < 2; ++n) _Pragma("unroll") for (int k = 0; k < 2; ++k) dst[n][k] = *(const PG8_LAS bf16x8*)(lds + PG8_SB(b, h) + boff + n * 2048 + k * 1024); } while (0)
#define PG8_MMA(ai, bj, At, Bt) do { __builtin_amdgcn_s_setprio(1); _Pragma("unroll") for (int m = 0; m < 4; ++m) _Pragma("unroll") for (int n = 0; n < 2; ++n) _Pragma("unroll") for (int k = 0; k < 2; ++k) \
        acc[ai][bj][m][n] = __builtin_amdgcn_mfma_f32_16x16x32_bf16(Bt[n][k], At[m][k], acc[ai][bj][m][n], 0, 0, 0); __builtin_amdgcn_s_setprio(0); } while (0)
#define PG8_WAIT_V(n) asm volatile("s_waitcnt vmcnt(" #n ")" ::: "memory")
#define PG8_WAIT_L(n) asm volatile("s_waitcnt lgkmcnt(" #n ")" ::: "memory")
#define PG8_BAR __builtin_amdgcn_s_barrier()
#define PG8_SCHED __builtin_amdgcn_sched_barrier(0)
    Unit cur, nxt; int ui = 0;
    if (!S.next(0, cur)) return;
    f32x4 acc[2][2][4][2];
#pragma unroll
    for (int a = 0; a < 2; ++a)
#pragma unroll
        for (int b = 0; b < 2; ++b)
#pragma unroll
            for (int m = 0; m < 4; ++m)
#pragma unroll
                for (int n = 0; n < 2; ++n) acc[a][b][m][n] = (f32x4){0.f, 0.f, 0.f, 0.f};
    bf16x8 At[4][2], B0[2][2], B1[2][2];
    const char* cA = (const char*)g.A + (size_t)cur.pm * tstep; const char* cB = (const char*)g.Bt + (size_t)cur.pn * tstep;
    S.a_ready(cur);
    if constexpr (SP2) {
        PG8_STAGE(PG8_SB(0, 0), cB, voffB); PG8_STAGE(PG8_SB(0, 1), cB + hstep, voffB); PG8_STAGE(PG8_SA(0, 0), cA, voffA); PG8_STAGE(PG8_SA(0, 1), cA + hstep, voffA);
        if (wr == 1) PG8_BAR;
        PG8_WAIT_V(2); PG8_BAR;
        PG8_STAGE(PG8_SB(1, 0), cB + kstep, voffB); PG8_STAGE(PG8_SA(1, 0), cA + kstep, voffA); PG8_STAGE(PG8_SB(1, 1), cB + hstep + kstep, voffB);
        PG8_WAIT_V(6); PG8_BAR;
    } else {
        PG8_STAGE(PG8_SB(0, 0), cB, voffB); PG8_STAGE(PG8_SA(0, 0), cA, voffA); PG8_STAGE(PG8_SB(0, 1), cB + hstep, voffB); PG8_STAGE(PG8_SA(0, 1), cA + hstep, voffA);
        if (wr == 1) PG8_BAR;
        PG8_WAIT_V(4); PG8_BAR;
        PG8_STAGE(PG8_SB(1, 0), cB + kstep, voffB); PG8_STAGE(PG8_SA(1, 0), cA + kstep, voffA); PG8_STAGE(PG8_SB(1, 1), cB + hstep + kstep, voffB);
        PG8_WAIT_V(6); PG8_BAR;
    }
    for (;;) {
        const bool has_next = S.next(ui + 1, nxt);
        const char* nA = has_next ? (const char*)g.A + (size_t)nxt.pm * tstep : cA; const char* nB = has_next ? (const char*)g.Bt + (size_t)nxt.pn * tstep : cB;
#pragma nounroll
        for (int t = 0; t < nt; t += 2) {
            const bool last = (t == nt - 2);
            const char* a1 = cA + (size_t)(t + 1) * kstep;
            const char* a2 = last ? nA : cA + (size_t)(t + 2) * kstep; const char* b2 = last ? nB : cB + (size_t)(t + 2) * kstep;
            const char* a3 = a2 + kstep; const char* b3 = b2 + kstep;
            if (last && has_next) S.a_ready(nxt);
            if constexpr (SP2) {
            PG8_LDB(B0, 0, 0); PG8_LDB(B1, 0, 1); PG8_SCHED; PG8_LDA(At, 0, 0); PG8_STAGE(PG8_SA(1, 1), a1 + hstep, voffA);
            PG8_WAIT_V(8); PG8_WAIT_L(0); PG8_BAR; PG8_MMA(0, 0, At, B0); PG8_MMA(0, 1, At, B1); PG8_BAR; PG8_SCHED;
            PG8_LDA(At, 0, 1); PG8_STAGE(PG8_SB(0, 0), b2, voffB); PG8_STAGE(PG8_SB(0, 1), b2 + hstep, voffB); PG8_STAGE(PG8_SA(0, 0), a2, voffA);
            PG8_WAIT_V(8); PG8_WAIT_L(0); PG8_BAR; PG8_MMA(1, 0, At, B0); PG8_MMA(1, 1, At, B1); PG8_BAR; PG8_SCHED;
            PG8_LDB(B0, 1, 0); PG8_LDB(B1, 1, 1); PG8_SCHED; PG8_LDA(At, 1, 0); PG8_STAGE(PG8_SA(0, 1), a2 + hstep, voffA);
            PG8_WAIT_V(8); PG8_WAIT_L(0); PG8_BAR; PG8_MMA(0, 0, At, B0); PG8_MMA(0, 1, At, B1); PG8_BAR; PG8_SCHED;
            PG8_LDA(At, 1, 1); PG8_STAGE(PG8_SB(1, 0), b3, voffB); PG8_STAGE(PG8_SB(1, 1), b3 + hstep, voffB); PG8_STAGE(PG8_SA(1, 0), a3, voffA);
            PG8_WAIT_V(8); PG8_WAIT_L(0); PG8_BAR; PG8_MMA(1, 0, At, B0); PG8_MMA(1, 1, At, B1); PG8_BAR; PG8_SCHED;
            } else {
            PG8_LDB(B0, 0, 0); PG8_SCHED; PG8_LDA(At, 0, 0); PG8_STAGE(PG8_SA(1, 1), a1 + hstep, voffA);
            PG8_WAIT_L(8); PG8_BAR; PG8_WAIT_L(0); PG8_MMA(0, 0, At, B0); PG8_BAR; PG8_SCHED;
            PG8_LDB(B1, 0, 1); PG8_STAGE(PG8_SB(0, 0), b2, voffB);
            PG8_BAR; PG8_WAIT_L(0); PG8_MMA(0, 1, At, B1); PG8_BAR;
            PG8_LDA(At, 0, 1); PG8_STAGE(PG8_SA(0, 0), a2, voffA);
            PG8_BAR; PG8_WAIT_L(0); PG8_MMA(1, 0, At, B0); PG8_BAR; PG8_SCHED;
            PG8_STAGE(PG8_SB(0, 1), b2 + hstep, voffB);
            PG8_WAIT_V(6); PG8_BAR; PG8_MMA(1, 1, At, B1); PG8_BAR;
            PG8_LDB(B0, 1, 0); PG8_SCHED; PG8_LDA(At, 1, 0); PG8_STAGE(PG8_SA(0, 1), a2 + hstep, voffA);
            PG8_WAIT_L(8); PG8_BAR; PG8_WAIT_L(0); PG8_MMA(0, 0, At, B0); PG8_BAR; PG8_SCHED;
            PG8_LDB(B1, 1, 1); PG8_STAGE(PG8_SB(1, 0), b3, voffB);
            PG8_BAR; PG8_WAIT_L(0); PG8_MMA(0, 1, At, B1); PG8_BAR;
            PG8_LDA(At, 1, 1); PG8_STAGE(PG8_SA(1, 0), a3, voffA);
            PG8_BAR; PG8_WAIT_L(0); PG8_MMA(1, 0, At, B0); PG8_BAR; PG8_SCHED;
            PG8_STAGE(PG8_SB(1, 1), b3 + hstep, voffB);
            PG8_WAIT_V(6); PG8_BAR; PG8_MMA(1, 1, At, B1); PG8_BAR;
            }
        }
        if constexpr (ALIGN_EPI) { if (wr == 0) PG8_BAR; }
        if constexpr (!Epi::AFTER_DRAIN) { E(acc, cur, wr, wc, fr, fq); S.done(cur); }
        if (!has_next) break;
#pragma unroll
        for (int a = 0; a < 2; ++a)
#pragma unroll
            for (int b = 0; b < 2; ++b)
#pragma unroll
                for (int m = 0; m < 4; ++m)
#pragma unroll
                    for (int n = 0; n < 2; ++n) acc[a][b][m][n] = (f32x4){0.f, 0.f, 0.f, 0.f};
        cur = nxt; cA = nA; cB = nB; ++ui;
        if constexpr (ALIGN_EPI) { if (wr == 1) PG8_BAR; }
    }
    PG8_WAIT_V(0);
    if constexpr (!ALIGN_EPI) { if (wr == 0) PG8_BAR; }
    PG8_BAR;
    if constexpr (Epi::AFTER_DRAIN) { E.fused(acc, cur, wr, wc, fr, fq, lds, wid, lane); S.done(cur); }
#undef PG8_SA
#undef PG8_SB
#undef PG8_STAGE
#undef PG8_LDA
#undef PG8_LDB
#undef PG8_MMA
#undef PG8_WAIT_V
#undef PG8_WAIT_L
#undef PG8_BAR
#undef PG8_SCHED
}
}
#define LAS __attribute__((address_space(3)))
using pg8::bf16_t; using pg8::bf16x8; using pg8::f32x4; using pg8::u32x4;
typedef float f32x16 __attribute__((ext_vector_type(16)));
typedef unsigned u32x2 __attribute__((ext_vector_type(2)));
typedef float f32x2 __attribute__((ext_vector_type(2)));

constexpr int T = 32768, D = 1024, NB = 16, SEQ = 2048, FF = 2816;
constexpr float ALPHA = 1.4142135623730951f;
constexpr float EPS = 1e-5f;
constexpr float LOG2E = 1.4426950408889634f;
constexpr float C2_MLA = 0.07216878364870323f * LOG2E;
constexpr float C2_FOX = 0.125f * LOG2E;
constexpr int MODW = 6 * D;

constexpr size_t MiB = 1u << 20;
constexpr size_t WS_WIN0 = 0, WS_WUQ = 2 * MiB, WS_WUKV = 3 * MiB, WS_WO0 = 4 * MiB, WS_WFIN = 6 * MiB, WS_WO1 = 13 * MiB;
constexpr size_t WS_WGU0 = 15 * MiB, WS_WGU1 = 26 * MiB, WS_WD0 = 37 * MiB, WS_WD1 = 43 * MiB;
constexpr size_t WS_MOD = 49 * MiB, WS_STATS = 50 * MiB, WS_SSQ = 51 * MiB, WS_LOGF = 52 * MiB, WS_GNEG = 54 * MiB, WS_CS = 56 * MiB;
constexpr size_t WS_U = 64 * MiB, WS_HQ = 128 * MiB, WS_HKV = 144 * MiB, WS_KROPE = 160 * MiB;
constexpr size_t WS_BIG = 164 * MiB;
constexpr size_t WS_Q = WS_BIG, WS_KNOPE = WS_BIG + 96 * MiB, WS_VT = WS_BIG + 160 * MiB;
constexpr size_t WS_QF = WS_BIG, WS_KF = WS_BIG + 64 * MiB;
constexpr size_t WS_H = WS_BIG;
constexpr size_t WS_END = WS_BIG + 224 * MiB;

constexpr int LDS_BYTES = 147456;

__device__ __forceinline__ unsigned cvt_pk_bf16(float lo, float hi) { unsigned r; asm volatile("v_cvt_pk_bf16_f32 %0, %1, %2" : "=v"(r) : "v"(lo), "v"(hi)); return r; }
__device__ __forceinline__ u32x2 pack4(f32x4 v) { u32x2 w; w.x = cvt_pk_bf16(v[0], v[1]); w.y = cvt_pk_bf16(v[2], v[3]); return w; }
__device__ __forceinline__ float wave_sum(float v) {
#pragma unroll
    for (int o = 1; o < 64; o <<= 1) v += __shfl_xor(v, o);
    return v;
}

struct Params { const float* in[20]; float* out; unsigned char* ws; };


struct EpiMlaIn {
    static constexpr bool PERM = false, AFTER_DRAIN = false;
    bf16_t* hq; bf16_t* hkv; bf16_t* krope; float* ssq; const float* cs;
    __device__ __forceinline__ void operator()(const f32x4 (&acc)[2][2][4][2], const pg8::Unit& u, int wr, int wc, int fr, int fq) const {
        if (u.pn < 2) {
            bf16_t* dst = u.pn == 0 ? hq : hkv;
#pragma unroll
            for (int ai = 0; ai < 2; ++ai)
#pragma unroll
                for (int m = 0; m < 4; ++m) {
                    const int row = u.pm * 256 + ai * 128 + wr * 64 + m * 16 + fr; float s = 0.f;
#pragma unroll
                    for (int bj = 0; bj < 2; ++bj)
#pragma unroll
                        for (int n = 0; n < 2; ++n) { const f32x4 v = acc[ai][bj][m][n]; s += (v[0] * v[0] + v[1] * v[1]) + (v[2] * v[2] + v[3] * v[3]);
                            *(u32x2*)(dst + (size_t)row * 256 + bj * 128 + wc * 32 + n * 16 + fq * 4) = pack4(v); }
                    s += __shfl_xor(s, 16); s += __shfl_xor(s, 32);
                    if (fq == 0) ssq[((size_t)row * 2 + u.pn) * 4 + wc] = s; asm volatile("" ::: "memory");
                }
        } else if (wc < 2) {
            const int i0 = 16 * wc + 4 * fq;
#pragma unroll
            for (int ai = 0; ai < 2; ++ai)
#pragma unroll
                for (int m = 0; m < 4; ++m) {
                    const int row = u.pm * 256 + ai * 128 + wr * 64 + m * 16 + fr;
                    const f32x4 x1 = acc[ai][0][m][0], x2 = acc[ai][0][m][1];
                    const f32x4 ca = *(const f32x4*)(cs + ((size_t)row * 32 + i0) * 2), cb = *(const f32x4*)(cs + ((size_t)row * 32 + i0) * 2 + 4);
                    const f32x4 c = {ca[0], ca[2], cb[0], cb[2]}, sn = {ca[1], ca[3], cb[1], cb[3]};
                    const f32x4 o1 = x1 * c - x2 * sn, o2 = x2 * c + x1 * sn;
                    *(u32x2*)(krope + (size_t)row * 64 + i0) = pack4(o1);
                    *(u32x2*)(krope + (size_t)row * 64 + 32 + i0) = pack4(o2); asm volatile("" ::: "memory");
                }
        }
    }
};

struct EpiQ {
    static constexpr bool PERM = false, AFTER_DRAIN = false;
    bf16_t* Q; const float* ssq; const float* cs;
    __device__ __forceinline__ void operator()(const f32x4 (&acc)[2][2][4][2], const pg8::Unit& u, int wr, int wc, int fr, int fq) const {
#pragma unroll
        for (int ai = 0; ai < 2; ++ai)
#pragma unroll
            for (int m = 0; m < 4; ++m) {
                const int row = u.pm * 256 + ai * 128 + wr * 64 + m * 16 + fr;
                const f32x4 sp = *(const f32x4*)(ssq + ((size_t)row * 2 + 0) * 4);
                const float rs = C2_MLA / sqrtf(((sp[0] + sp[1]) + (sp[2] + sp[3])) * (1.f / 256.f) + EPS);
#pragma unroll
                for (int bj = 0; bj < 2; ++bj) {
                    const int c32 = u.pn * 256 + bj * 128 + wc * 32, h = c32 / 192, w32 = c32 - h * 192;
                    if (w32 < 128) {
#pragma unroll
                        for (int n = 0; n < 2; ++n) *(u32x2*)(Q + (size_t)row * 1536 + c32 + n * 16 + fq * 4) = pack4(acc[ai][bj][m][n] * rs);
                    } else {
                        const int i0 = 16 * ((w32 - 128) >> 5) + 4 * fq;
                        const f32x4 x1 = acc[ai][bj][m][0] * rs, x2 = acc[ai][bj][m][1] * rs;
                        const f32x4 ca = *(const f32x4*)(cs + ((size_t)row * 32 + i0) * 2), cb = *(const f32x4*)(cs + ((size_t)row * 32 + i0) * 2 + 4);
                        const f32x4 c = {ca[0], ca[2], cb[0], cb[2]}, sn = {ca[1], ca[3], cb[1], cb[3]};
                        const f32x4 o1 = x1 * c - x2 * sn, o2 = x2 * c + x1 * sn;
                        *(u32x2*)(Q + (size_t)row * 1536 + h * 192 + 128 + i0) = pack4(o1);
                        *(u32x2*)(Q + (size_t)row * 1536 + h * 192 + 128 + 32 + i0) = pack4(o2);
                    }
                }
                asm volatile("" ::: "memory");
            }
    }
};

struct EpiKV {
    static constexpr bool PERM = false, AFTER_DRAIN = false;
    bf16_t* Kn; bf16_t* Vt; const float* ssq;
    __device__ __forceinline__ void operator()(const f32x4 (&acc)[2][2][4][2], const pg8::Unit& u, int wr, int wc, int fr, int fq) const {
#pragma unroll
        for (int ai = 0; ai < 2; ++ai)
#pragma unroll
            for (int m = 0; m < 4; ++m) {
                const int row = u.pm * 256 + ai * 128 + wr * 64 + m * 16 + fr;
                const f32x4 sp = *(const f32x4*)(ssq + ((size_t)row * 2 + 1) * 4);
                const float rs = 1.f / sqrtf(((sp[0] + sp[1]) + (sp[2] + sp[3])) * (1.f / 256.f) + EPS);
                const int b = row >> 11, s = row & 2047;
#pragma unroll
                for (int bj = 0; bj < 2; ++bj)
#pragma unroll
                    for (int n = 0; n < 2; ++n) {
                        const int col = u.pn * 256 + bj * 128 + wc * 32 + n * 16 + fq * 4; const f32x4 v = acc[ai][bj][m][n] * rs;
                        if (u.pn < 4) *(u32x2*)(Kn + (size_t)row * 1024 + col) = pack4(v);
                        else { const u32x2 w = pack4(v); const int vc = col - 1024;
                            bf16_t* p = Vt + ((size_t)b * 1024 + vc) * 2048 + s;
                            p[0] = (bf16_t)(w.x & 0xffffu); p[2048] = (bf16_t)(w.x >> 16); p[4096] = (bf16_t)(w.y & 0xffffu); p[6144] = (bf16_t)(w.y >> 16); }
                    }
                asm volatile("" ::: "memory");
            }
    }
};

struct EpiFoxIn {
    static constexpr bool PERM = false, AFTER_DRAIN = false;
    bf16_t* Qf; bf16_t* Kf; bf16_t* Vt; float* logf; const float* bf;
    __device__ __forceinline__ void operator()(const f32x4 (&acc)[2][2][4][2], const pg8::Unit& u, int wr, int wc, int fr, int fq) const {
#pragma unroll
        for (int ai = 0; ai < 2; ++ai)
#pragma unroll
            for (int m = 0; m < 4; ++m) {
                const int row = u.pm * 256 + ai * 128 + wr * 64 + m * 16 + fr;
                const int b = row >> 11, s = row & 2047;
                if (u.pn == 12) {
                    if (wc == 0) { const f32x4 v = acc[ai][0][m][0]; const f32x4 bb = *(const f32x4*)(bf + 4 * fq); f32x4 o;
#pragma unroll
                        for (int e = 0; e < 4; ++e) { const float x = v[e] + bb[e]; o[e] = fminf(x, 0.f) - log1pf(__expf(-fabsf(x))); }
                        *(f32x4*)(logf + (size_t)row * 16 + 4 * fq) = o; }
                } else {
#pragma unroll
                    for (int bj = 0; bj < 2; ++bj)
#pragma unroll
                        for (int n = 0; n < 2; ++n) {
                            const int col = u.pn * 256 + bj * 128 + wc * 32 + n * 16 + fq * 4; const f32x4 v = acc[ai][bj][m][n];
                            if (u.pn < 4) *(u32x2*)(Qf + (size_t)row * 1024 + col) = pack4(v * C2_FOX);
                            else if (u.pn < 8) *(u32x2*)(Kf + (size_t)row * 1024 + col - 1024) = pack4(v);
                            else { const u32x2 w = pack4(v); const int vc = col - 2048;
                                bf16_t* p = Vt + ((size_t)b * 1024 + vc) * 2048 + s;
                                p[0] = (bf16_t)(w.x & 0xffffu); p[2048] = (bf16_t)(w.x >> 16); p[4096] = (bf16_t)(w.y & 0xffffu); p[6144] = (bf16_t)(w.y >> 16); }
                        }
                }
                asm volatile("" ::: "memory");
            }
    }
};

template <bool FIRST> struct EpiRes {
    static constexpr bool PERM = false, AFTER_DRAIN = false;
    const float* xin; float* z; const float* stats; const float* lng; const float* lnb; const float* gate;
    __device__ __forceinline__ void operator()(const f32x4 (&acc)[2][2][4][2], const pg8::Unit& u, int wr, int wc, int fr, int fq) const {
        const int b = (u.pm * 256) >> 11;
#pragma unroll
        for (int bj = 0; bj < 2; ++bj)
#pragma unroll
            for (int n = 0; n < 2; ++n) {
                const int col = u.pn * 256 + bj * 128 + wc * 32 + n * 16 + fq * 4;
                const f32x4 gt = *(const f32x4*)(gate + (size_t)b * MODW + col) + 1.0f;
                f32x4 g = {0.f, 0.f, 0.f, 0.f}, bb = {0.f, 0.f, 0.f, 0.f};
                if (!FIRST) { g = *(const f32x4*)(lng + col); bb = *(const f32x4*)(lnb + col); }
#pragma unroll
                for (int ai = 0; ai < 2; ++ai)
#pragma unroll
                    for (int m = 0; m < 4; ++m) {
                        const int row = u.pm * 256 + ai * 128 + wr * 64 + m * 16 + fr; const size_t off = (size_t)row * 1024 + col;
                        f32x4 x;
                        if (FIRST) x = *(const f32x4*)(xin + off);
                        else { const f32x2 st = *(const f32x2*)(stats + (size_t)row * 2); x = (*(const f32x4*)(z + off) - st.x) * st.y * g + bb; }
                        *(f32x4*)(z + off) = x * ALPHA + gt * acc[ai][bj][m][n];
                        if (m & 1) asm volatile("" ::: "memory");
                    }
            }
    }
};

struct EpiSwiGLU {
    static constexpr bool PERM = false, AFTER_DRAIN = false;
    bf16_t* H;
    __device__ __forceinline__ void operator()(const f32x4 (&acc)[2][2][4][2], const pg8::Unit& u, int wr, int wc, int fr, int fq) const {
#pragma unroll
        for (int ai = 0; ai < 2; ++ai)
#pragma unroll
            for (int m = 0; m < 4; ++m) {
                const int row = u.pm * 256 + ai * 128 + wr * 64 + m * 16 + fr;
#pragma unroll
                for (int bj = 0; bj < 2; ++bj) {
                    const int hc = (u.pn * 256 + bj * 128 + wc * 32) / 2 + 4 * fq;
                    const f32x4 g = acc[ai][bj][m][0], up = acc[ai][bj][m][1]; f32x4 o;
#pragma unroll
                    for (int e = 0; e < 4; ++e) o[e] = g[e] * up[e] * __builtin_amdgcn_rcpf(1.f + __builtin_amdgcn_exp2f(-g[e] * LOG2E));
                    *(u32x2*)(H + (size_t)row * FF + hc) = pack4(o);
                }
            }
    }
};

enum { MAP_ID = 0, MAP_MLAIN = 1, MAP_UQ = 2, MAP_GU = 3 };
struct TrJob { const float* src0; long delta; const float* kscale; bf16_t* dst; int ldw, K, Npad, nvalid, map; };
__device__ __forceinline__ int map_col(int map, int j, int nvalid, int& which) {
    which = 0;
    if (map == MAP_ID) return j < nvalid ? j : -1;
    if (map == MAP_MLAIN) { if (j < 512) return j; if (j >= 576) return -1; const int jj = j - 512, g2 = jj >> 5, r = jj & 31; return 512 + 16 * g2 + (r & 15) + 32 * (r >> 4); }
    if (map == MAP_UQ) { const int h = j / 192, w = j - h * 192; if (w < 128) return j; const int jj = w - 128, g2 = jj >> 5, r = jj & 31; return h * 192 + 128 + 16 * g2 + (r & 15) + 32 * (r >> 4); }
    { const int g32 = j >> 5, r = j & 31; which = r >> 4; return 16 * g32 + (r & 15); }
}
__device__ __forceinline__ void tr_item(const TrJob& J, LAS float* scr, int item, int lane) {
    const int nblk = J.Npad / 32, kb = item / nblk, nb = item - kb * nblk, k0 = 64 * kb, n0 = 32 * nb;
    int which; const int sc = map_col(J.map, n0 + (lane & 31), J.nvalid, which);
    const float* W = J.src0 + (which ? J.delta : 0L);
#pragma unroll 8
    for (int i = 0; i < 32; ++i) { const int kk = 2 * i + (lane >> 5); float v = 0.f;
        if (sc >= 0) { v = W[(size_t)(k0 + kk) * J.ldw + sc]; if (J.kscale) v *= J.kscale[k0 + kk]; }
        scr[kk * 33 + (lane & 31)] = v; }
    asm volatile("s_waitcnt lgkmcnt(0)" ::: "memory");
    const int c = lane & 7;
#pragma unroll
    for (int j = 0; j < 4; ++j) { const int n = (lane >> 3) + 8 * j; const LAS float* s = scr + (8 * c) * 33 + n;
        u32x4 o; o.x = cvt_pk_bf16(s[0 * 33], s[1 * 33]); o.y = cvt_pk_bf16(s[2 * 33], s[3 * 33]); o.z = cvt_pk_bf16(s[4 * 33], s[5 * 33]); o.w = cvt_pk_bf16(s[6 * 33], s[7 * 33]);
        *(u32x4*)(J.dst + (size_t)(n0 + n) * J.K + k0 + 8 * c) = o; }
    asm volatile("s_waitcnt lgkmcnt(0)" ::: "memory");
}
constexpr int N_TRJOBS = 11;
__device__ __forceinline__ TrJob get_job(const Params& P, int id) {
    unsigned char* ws = P.ws; TrJob J; J.delta = 0; J.kscale = nullptr; J.map = MAP_ID;
    switch (id) {
    case 0: J.src0 = P.in[3]; J.dst = (bf16_t*)(ws + WS_WIN0); J.ldw = 576; J.K = 1024; J.Npad = 768; J.nvalid = 576; J.map = MAP_MLAIN; break;
    case 1: J.src0 = P.in[5]; J.kscale = P.in[4]; J.dst = (bf16_t*)(ws + WS_WUQ); J.ldw = 1536; J.K = 256; J.Npad = 1536; J.nvalid = 1536; J.map = MAP_UQ; break;
    case 2: J.src0 = P.in[7]; J.kscale = P.in[6]; J.dst = (bf16_t*)(ws + WS_WUKV); J.ldw = 1024; J.K = 256; J.Npad = 1024; J.nvalid = 1024; break;
    case 3: J.src0 = P.in[8]; J.kscale = P.in[6]; J.dst = (bf16_t*)(ws + WS_WUKV) + 1024 * 256; J.ldw = 1024; J.K = 256; J.Npad = 1024; J.nvalid = 1024; break;
    case 4: J.src0 = P.in[9]; J.dst = (bf16_t*)(ws + WS_WO0); J.ldw = 1024; J.K = 1024; J.Npad = 1024; J.nvalid = 1024; break;
    case 5: J.src0 = P.in[10]; J.dst = (bf16_t*)(ws + WS_WFIN); J.ldw = 3088; J.K = 1024; J.Npad = 3328; J.nvalid = 3088; break;
    case 6: J.src0 = P.in[12]; J.dst = (bf16_t*)(ws + WS_WO1); J.ldw = 1024; J.K = 1024; J.Npad = 1024; J.nvalid = 1024; break;
    case 7: J.src0 = P.in[15]; J.delta = (long)(P.in[16] - P.in[15]); J.dst = (bf16_t*)(ws + WS_WGU0); J.ldw = FF; J.K = 1024; J.Npad = 2 * FF; J.nvalid = 2 * FF; J.map = MAP_GU; break;
    case 8: J.src0 = P.in[15] + (size_t)D * FF; J.delta = (long)(P.in[16] - P.in[15]); J.dst = (bf16_t*)(ws + WS_WGU1); J.ldw = FF; J.K = 1024; J.Npad = 2 * FF; J.nvalid = 2 * FF; J.map = MAP_GU; break;
    case 9: J.src0 = P.in[17]; J.dst = (bf16_t*)(ws + WS_WD0); J.ldw = 1024; J.K = FF; J.Npad = 1024; J.nvalid = 1024; break;
    default: J.src0 = P.in[17] + (size_t)FF * D; J.dst = (bf16_t*)(ws + WS_WD1); J.ldw = 1024; J.K = FF; J.Npad = 1024; J.nvalid = 1024; break;
    }
    return J;
}
__device__ __forceinline__ void adaln_item(LAS float* lds, const Params& P, int item) {
    const int tid = tid_opaque(), lane = tid & 63, w = tid >> 6;
    const int i = item / 96, cg0 = (item - i * 96) * 64;
    const float* c = P.in[1]; const float* aw = P.in[13] + (size_t)i * D * MODW; const float* ab = P.in[14] + (size_t)i * MODW;
    float* mod = (float*)(P.ws + WS_MOD) + (size_t)i * 16 * MODW;
    for (int e = tid; e < 16 * 1024; e += 512) { const int b = e >> 10, k = e & 1023; const float v = c[e]; lds[k * 16 + b] = v / (1.f + __expf(-v)); }
    __syncthreads();
    f32x4 a0 = {0.f, 0.f, 0.f, 0.f}, a1 = a0, a2 = a0, a3 = a0;
    const float* wp = aw + (size_t)(128 * w) * MODW + cg0 + lane;
#pragma unroll 4
    for (int kk = 0; kk < 128; ++kk) {
        const float wv = wp[(size_t)kk * MODW];
        const LAS f32x4* cp = (const LAS f32x4*)(lds + (128 * w + kk) * 16);
        a0 += cp[0] * wv; a1 += cp[1] * wv; a2 += cp[2] * wv; a3 += cp[3] * wv;
    }
    LAS float* red = lds + 16384;
    { LAS float* rp = red + (w * 64 + lane) * 17;
#pragma unroll
      for (int e = 0; e < 4; ++e) { rp[e] = a0[e]; rp[4 + e] = a1[e]; rp[8 + e] = a2[e]; rp[12 + e] = a3[e]; } }
    __syncthreads();
#pragma unroll
    for (int r = 0; r < 2; ++r) { const int o = tid * 2 + r, cl = o >> 4, b = o & 15; float s = 0.f;
#pragma unroll
        for (int ww = 0; ww < 8; ++ww) s += red[(ww * 64 + cl) * 17 + b];
        mod[(size_t)b * MODW + cg0 + cl] = s + ab[cg0 + cl]; }
    __syncthreads();
}
__device__ __forceinline__ void sincos_acc(float ang, float& sn, float& cn) {
    const double a = (double)ang, n = __builtin_rint(a * 0.15915494309189535), r = a - n * 6.283185307179586477, r2 = r * r;
    double ts = r, tc = 1.0, ss = r, sc = 1.0;
#pragma unroll
    for (int k = 0; k < 13; ++k) { tc *= -r2 * (1.0 / (double)((2 * k + 1) * (2 * k + 2))); ts *= -r2 * (1.0 / (double)((2 * k + 2) * (2 * k + 3))); sc += tc; ss += ts; }
    sn = (float)ss; cn = (float)sc;
}
__device__ __forceinline__ void phase0(LAS unsigned char* L, const Params& P) {
    const int tid = tid_opaque(), lane = tid & 63, w = tid >> 6, G = gridDim.x;
    for (int it = blockIdx.x; it < 192; it += G) adaln_item((LAS float*)L, P, it);
    { const int* pos = (const int*)P.in[2]; float* cs = (float*)(P.ws + WS_CS);
      for (int e = blockIdx.x * 512 + tid; e < T * 32; e += G * 512) { const int t = e >> 5, i = e & 31;
          const float inv = (float)exp2(-(double)i * (13.287712379549449 / 32.0)); const float ang = (float)pos[t] * inv; float sn, cn; sincos_acc(ang, sn, cn);
          *(f32x2*)(cs + (size_t)e * 2) = (f32x2){cn, sn}; } }
    LAS float* scr = (LAS float*)L + w * (64 * 33);
    const int gw = blockIdx.x * 8 + w, NGW = G * 8;
    int base = 0;
#pragma unroll
    for (int id = 0; id < N_TRJOBS; ++id) {
        const TrJob J = get_job(P, id); const int nit = (J.K / 64) * (J.Npad / 32);
        int first = (gw - base) % NGW; if (first < 0) first += NGW;
        for (int it = first; it < nit; it += NGW) tr_item(J, scr, it, lane);
        base += nit;
    }
}

__device__ __forceinline__ void rows_modulate(const float* x, const float* sh, const float* sc, bf16_t* u) {
    const int lane = tid_opaque() & 63, gw = blockIdx.x * 8 + (tid_opaque() >> 6), NGW = gridDim.x * 8;
    for (int row = gw; row < T; row += NGW) { const int b = row >> 11;
#pragma unroll
        for (int j = 0; j < 4; ++j) { const int col = 4 * lane + 256 * j; const f32x4 v = *(const f32x4*)(x + (size_t)row * D + col);
            const f32x4 a = *(const f32x4*)(sc + (size_t)b * MODW + col) + 1.0f, s = *(const f32x4*)(sh + (size_t)b * MODW + col);
            *(u32x2*)(u + (size_t)row * D + col) = pack4(v * a + s); } }
}
template <bool FINAL> __device__ __forceinline__ void rows_ln(float* z, float* stats, const float* lng, const float* lnb, const float* sh, const float* sc, bf16_t* u) {
    const int lane = tid_opaque() & 63, gw = blockIdx.x * 8 + (tid_opaque() >> 6), NGW = gridDim.x * 8;
    for (int row = gw; row < T; row += NGW) { const int b = row >> 11;
        f32x4 v[4]; float s = 0.f;
#pragma unroll
        for (int j = 0; j < 4; ++j) { v[j] = *(const f32x4*)(z + (size_t)row * D + 4 * lane + 256 * j); s += (v[j][0] + v[j][1]) + (v[j][2] + v[j][3]); }
        const float mean = wave_sum(s) * (1.f / D); float q = 0.f;
#pragma unroll
        for (int j = 0; j < 4; ++j) { v[j] = v[j] - mean; q += (v[j][0] * v[j][0] + v[j][1] * v[j][1]) + (v[j][2] * v[j][2] + v[j][3] * v[j][3]); }
        const float rstd = 1.f / sqrtf(wave_sum(q) * (1.f / D) + EPS);
        if (!FINAL && lane == 0) *(f32x2*)(stats + (size_t)row * 2) = (f32x2){mean, rstd};
#pragma unroll
        for (int j = 0; j < 4; ++j) { const int col = 4 * lane + 256 * j;
            const f32x4 xn = v[j] * rstd * *(const f32x4*)(lng + col) + *(const f32x4*)(lnb + col);
            if (FINAL) *(f32x4*)(z + (size_t)row * D + col) = xn;
            else { const f32x4 a = *(const f32x4*)(sc + (size_t)b * MODW + col) + 1.0f, sft = *(const f32x4*)(sh + (size_t)b * MODW + col);
                *(u32x2*)(u + (size_t)row * D + col) = pack4(xn * a + sft); } } }
}
__device__ __forceinline__ void phase_cumsum(const float* logf, float* gneg) {
    const int lane = tid_opaque() & 63, gw = blockIdx.x * 8 + (tid_opaque() >> 6), NGW = gridDim.x * 8;
    for (int bh = gw; bh < 256; bh += NGW) { const int b = bh >> 4, h = bh & 15;
        const float* src = logf + ((size_t)b * SEQ + 32 * lane) * 16 + h; float v[32]; float run = 0.f;
#pragma unroll
        for (int i = 0; i < 32; ++i) { run += src[i * 16]; v[i] = run; }
        float incl = run;
#pragma unroll
        for (int o = 1; o < 64; o <<= 1) { const float t = __shfl_up(incl, o); if (lane >= o) incl += t; }
        const float excl = incl - run;
        float* dst = gneg + (size_t)bh * SEQ + 32 * lane;
#pragma unroll
        for (int i = 0; i < 32; i += 4) *(f32x4*)(dst + i) = (f32x4){-(excl + v[i]) * LOG2E, -(excl + v[i + 1]) * LOG2E, -(excl + v[i + 2]) * LOG2E, -(excl + v[i + 3]) * LOG2E}; }
}

template <int DQK, int DV, int NH, bool MLA, bool BIAS>
__device__ __forceinline__ void attn_phase(LAS unsigned char* lds, const bf16_t* __restrict__ Q, const bf16_t* __restrict__ K1, const bf16_t* __restrict__ K2,
                                           const bf16_t* __restrict__ Vt, const float* __restrict__ Gneg, bf16_t* __restrict__ O) {
    constexpr int LDQ = NH * DQK, NKC = DQK / 8, KBYTES = 64 * NKC * 16, VBYTES = DV * 128, BUF = KBYTES + VBYTES + 256;
    constexpr int KCH = 64 * NKC / 512, VCH = DV * 8 / 512, NS = DQK / 16, ND = DV / 32, KHD = MLA ? 128 : 64;
    static_assert(2 * BUF <= 131072, "attention LDS");
    const int tid = tid_opaque(), lane = tid & 63, w = __builtin_amdgcn_readfirstlane(tid >> 6), r32 = lane & 31, hi = lane >> 5;
    const int G = gridDim.x, bx = blockIdx.x, vcu = (G % 8 == 0) ? (bx % 8) * (G / 8) + bx / 8 : bx;
    const int pi = (r32 & ~12) | ((r32 & 4) << 1) | ((r32 & 8) >> 1);
    int koff[KCH]; bool krope[KCH]; int voff[VCH];
#pragma unroll
    for (int i = 0; i < KCH; ++i) { const int c = tid + 512 * i, row = c / NKC, slot = c - row * NKC, q = slot ^ ((row >> 1) & 7);
        krope[i] = MLA && q >= 16; koff[i] = krope[i] ? row * 64 + (q - 16) * 8 : row * 1024 + q * 8; }
#pragma unroll
    for (int i = 0; i < VCH; ++i) { const int c = tid + 512 * i, d = c >> 3, q = (c & 7) ^ ((d >> 1) & 7); voff[i] = d * SEQ + q * 8; }
    int kro[4], vro[4];
    { const int gk = hi ^ ((pi >> 1) & 7), gv = hi ^ ((r32 >> 1) & 7);
#pragma unroll
      for (int j = 0; j < 4; ++j) { kro[j] = pi * NKC * 16 + ((2 * j) ^ gk) * 16; vro[j] = r32 * 128 + ((2 * j) ^ gv) * 16; } }
    constexpr int NPAIRS = NB * NH * 4;
    for (int p = vcu; p < NPAIRS; p += G)
        for (int half = 0; half < 2; ++half) {
            const int bh = p >> 2, sidx = p & 3, qb = half ? 7 - sidx : sidx, b = bh / NH, h = bh - b * NH;
            const int q0 = qb * 256; const size_t rowbase = (size_t)b * SEQ;
            const int NT = 4 * (qb + 1), tl = 4 * qb + (w >> 1);
            bf16x8 qf[NS];
            { const bf16_t* qp = Q + (rowbase + q0 + 32 * w + r32) * LDQ + h * DQK + hi * 8;
#pragma unroll
              for (int s = 0; s < NS; ++s) qf[s] = *(const bf16x8*)(qp + 16 * s); }
            f32x16 o[ND];
#pragma unroll
            for (int d = 0; d < ND; ++d)
#pragma unroll
                for (int r = 0; r < 16; ++r) o[d][r] = 0.f;
            float mrun = -INFINITY, lrun = 0.f;
            f32x4 breg = {0.f, 0.f, 0.f, 0.f};
            const bf16_t* k1b = K1 + rowbase * 1024 + h * KHD; const bf16_t* k2b = MLA ? K2 + rowbase * 64 : K1; const bf16_t* vb = Vt + (size_t)bh * DV * SEQ;
#define ATT_DMA(t, buf) do { \
    _Pragma("unroll") for (int i = 0; i < KCH; ++i) { const bf16_t* src = krope[i] ? k2b + (size_t)(t) * (64 * 64) + koff[i] : k1b + (size_t)(t) * (64 * 1024) + koff[i]; \
        __builtin_amdgcn_global_load_lds((const unsigned*)src, (LAS unsigned*)(lds + (buf) * BUF + (512 * i + 64 * w) * 16), 16, 0, 0); } \
    _Pragma("unroll") for (int i = 0; i < VCH; ++i) \
        __builtin_amdgcn_global_load_lds((const unsigned*)(vb + 64 * (t) + voff[i]), (LAS unsigned*)(lds + (buf) * BUF + KBYTES + (512 * i + 64 * w) * 16), 16, 0, 0); \
    if (BIAS && tid < 16) breg = *(const f32x4*)(Gneg + (size_t)bh * SEQ + 64 * (t) + 4 * tid); } while (0)
#define ATT_BSTORE(buf) do { if (BIAS && tid < 16) *(LAS f32x4*)(lds + (buf) * BUF + KBYTES + VBYTES + 16 * tid) = breg; } while (0)
            ATT_DMA(0, 0); ATT_BSTORE(0); __syncthreads();
            for (int t = 0; t < NT; ++t) {
                const bool more = t + 1 < NT;
                if (more) ATT_DMA(t + 1, (t + 1) & 1);
                if (t <= tl) {
                    const LAS unsigned char* Bc = lds + (t & 1) * BUF;
                    f32x16 pp[2];
#pragma unroll
                    for (int blk = 0; blk < 2; ++blk) {
                        if (BIAS) {
#pragma unroll
                            for (int s2 = 0; s2 < 2; ++s2) { const LAS f32x4* bp = (const LAS f32x4*)(Bc + KBYTES + VBYTES + (32 * blk + 16 * s2 + 8 * hi) * 4); const f32x4 b0 = bp[0], b1 = bp[1];
                                pp[blk][8 * s2 + 0] = b0[0]; pp[blk][8 * s2 + 1] = b0[1]; pp[blk][8 * s2 + 2] = b0[2]; pp[blk][8 * s2 + 3] = b0[3];
                                pp[blk][8 * s2 + 4] = b1[0]; pp[blk][8 * s2 + 5] = b1[1]; pp[blk][8 * s2 + 6] = b1[2]; pp[blk][8 * s2 + 7] = b1[3]; }
                        } else {
#pragma unroll
                            for (int r = 0; r < 16; ++r) pp[blk][r] = 0.f;
                        }
                        const LAS unsigned char* kp = Bc + blk * (32 * NKC * 16);
#pragma unroll
                        for (int s = 0; s < NS; ++s) { const bf16x8 a = *(const LAS bf16x8*)(kp + kro[s & 3] + (s >> 2) * 128); pp[blk] = __builtin_amdgcn_mfma_f32_32x32x16_bf16(a, qf[s], pp[blk], 0, 0, 0);
                            if ((s & 1) == 1) __builtin_amdgcn_sched_barrier(0); }
                    }
                    if (t == tl) {
                        const int qrel = q0 + 32 * w + r32 - 64 * t;
#pragma unroll
                        for (int blk = 0; blk < 2; ++blk)
#pragma unroll
                            for (int r = 0; r < 16; ++r) { const int krel = 32 * blk + 16 * (r >> 3) + 8 * hi + (r & 7); if (krel > qrel) pp[blk][r] = -INFINITY; }
                    }
                    float mx = fmaxf(pp[0][0], pp[1][0]);
#pragma unroll
                    for (int r = 1; r < 16; ++r) mx = fmaxf(mx, fmaxf(pp[0][r], pp[1][r]));
                    mx = fmaxf(mx, __shfl_xor(mx, 32));
                    const float mnew = fmaxf(mrun, mx), alpha = __builtin_amdgcn_exp2f(mrun - mnew); mrun = mnew;
                    float rs = 0.f;
#pragma unroll
                    for (int blk = 0; blk < 2; ++blk)
#pragma unroll
                        for (int r = 0; r < 16; ++r) { const float e = __builtin_amdgcn_exp2f(pp[blk][r] - mnew); pp[blk][r] = e; rs += e; }
                    lrun = lrun * alpha + rs;
#pragma unroll
                    for (int d = 0; d < ND; ++d)
#pragma unroll
                        for (int r = 0; r < 16; ++r) o[d][r] *= alpha;
                    bf16x8 pb[2][2];
#pragma unroll
                    for (int blk = 0; blk < 2; ++blk)
#pragma unroll
                        for (int s2 = 0; s2 < 2; ++s2) { u32x4 wv; wv.x = cvt_pk_bf16(pp[blk][8 * s2 + 0], pp[blk][8 * s2 + 1]); wv.y = cvt_pk_bf16(pp[blk][8 * s2 + 2], pp[blk][8 * s2 + 3]);
                            wv.z = cvt_pk_bf16(pp[blk][8 * s2 + 4], pp[blk][8 * s2 + 5]); wv.w = cvt_pk_bf16(pp[blk][8 * s2 + 6], pp[blk][8 * s2 + 7]); pb[blk][s2] = __builtin_bit_cast(bf16x8, wv); }
                    __builtin_amdgcn_sched_barrier(0);
#pragma unroll
                    for (int d = 0; d < ND; ++d) { const LAS unsigned char* vp = Bc + KBYTES + d * (32 * 128);
#pragma unroll
                        for (int blk = 0; blk < 2; ++blk)
#pragma unroll
                            for (int s2 = 0; s2 < 2; ++s2) { const bf16x8 a = *(const LAS bf16x8*)(vp + vro[2 * blk + s2]); o[d] = __builtin_amdgcn_mfma_f32_32x32x16_bf16(a, pb[blk][s2], o[d], 0, 0, 0); }
                        __builtin_amdgcn_sched_barrier(0); }
                }
                if (more) ATT_BSTORE((t + 1) & 1);
                __syncthreads();
            }
#undef ATT_DMA
#undef ATT_BSTORE
            lrun += __shfl_xor(lrun, 32);
            const float inv = 1.f / lrun;
            bf16_t* op = O + (rowbase + q0 + 32 * w + r32) * 1024 + h * DV + 4 * hi;
#pragma unroll
            for (int d = 0; d < ND; ++d)
#pragma unroll
                for (int g = 0; g < 4; ++g) { const f32x4 v = {o[d][4 * g] * inv, o[d][4 * g + 1] * inv, o[d][4 * g + 2] * inv, o[d][4 * g + 3] * inv};
                    *(u32x2*)(op + 32 * d + 8 * g) = pack4(v); }
        }
}

template <class Epi> __device__ __forceinline__ void run_gemm(LAS unsigned char* L, const bf16_t* A, const bf16_t* Bt, int N, int K, const Epi& E) {
    pg8::Gemm g{A, Bt, T, N, K}; pg8::StaticOrder S; S.init(T, N, (int)gridDim.x, (int)blockIdx.x);
    pg8::gemm_phase<Epi, pg8::StaticOrder, true, true>(L, g, S, E);
}

typedef __attribute__((address_space(4))) const Params CParams;
#define PH_BEGIN CParams* q = Pm; asm volatile("" : "+s"(q)); unsigned char* const ws = q->ws; (void)ws;
#define WSP(T_, off) ((T_*)(ws + (off)))
__global__ void __launch_bounds__(512) mk_fwd(Params P_unused) {
    extern __shared__ __attribute__((aligned(16))) unsigned char lds_raw[];
    LAS unsigned char* L = (LAS unsigned char*)lds_raw;
    cg::grid_group grid = cg::this_grid();
    CParams* Pm = (CParams*)__builtin_amdgcn_kernarg_segment_ptr();
    { PH_BEGIN; Params Pl;
#pragma unroll
      for (int i = 0; i < 20; ++i) Pl.in[i] = q->in[i];
      Pl.out = q->out; Pl.ws = ws; phase0(L, Pl); }
    grid.sync();
    { PH_BEGIN; const float* mod0 = WSP(float, WS_MOD); rows_modulate(q->in[0], mod0 + 0 * D, mod0 + 1 * D, WSP(bf16_t, WS_U)); }
    grid.sync();
    { PH_BEGIN; EpiMlaIn E{WSP(bf16_t, WS_HQ), WSP(bf16_t, WS_HKV), WSP(bf16_t, WS_KROPE), WSP(float, WS_SSQ), WSP(float, WS_CS)}; run_gemm(L, WSP(bf16_t, WS_U), WSP(bf16_t, WS_WIN0), 768, 1024, E); }
    grid.sync();
    { PH_BEGIN; EpiQ E{WSP(bf16_t, WS_Q), WSP(float, WS_SSQ), WSP(float, WS_CS)}; run_gemm(L, WSP(bf16_t, WS_HQ), WSP(bf16_t, WS_WUQ), 1536, 256, E); }
    { PH_BEGIN; EpiKV E{WSP(bf16_t, WS_KNOPE), WSP(bf16_t, WS_VT), WSP(float, WS_SSQ)}; run_gemm(L, WSP(bf16_t, WS_HKV), WSP(bf16_t, WS_WUKV), 2048, 256, E); }
    grid.sync();
    { PH_BEGIN; attn_phase<192, 128, 8, true, false>(L, WSP(bf16_t, WS_Q), WSP(bf16_t, WS_KNOPE), WSP(bf16_t, WS_KROPE), WSP(bf16_t, WS_VT), nullptr, WSP(bf16_t, WS_U)); }
    grid.sync();
    { PH_BEGIN; EpiRes<true> E{q->in[0], q->out, nullptr, nullptr, nullptr, WSP(float, WS_MOD) + 2 * D}; run_gemm(L, WSP(bf16_t, WS_U), WSP(bf16_t, WS_WO0), 1024, 1024, E); }
    grid.sync();
    { PH_BEGIN; const float* mod0 = WSP(float, WS_MOD); rows_ln<false>(q->out, WSP(float, WS_STATS), q->in[18] + 0 * D, q->in[19] + 0 * D, mod0 + 3 * D, mod0 + 4 * D, WSP(bf16_t, WS_U)); }
    grid.sync();
    { PH_BEGIN; EpiSwiGLU E{WSP(bf16_t, WS_H)}; run_gemm(L, WSP(bf16_t, WS_U), WSP(bf16_t, WS_WGU0), 2 * FF, 1024, E); }
    grid.sync();
    { PH_BEGIN; EpiRes<false> E{nullptr, q->out, WSP(float, WS_STATS), q->in[18] + 0 * D, q->in[19] + 0 * D, WSP(float, WS_MOD) + 5 * D}; run_gemm(L, WSP(bf16_t, WS_H), WSP(bf16_t, WS_WD0), 1024, FF, E); }
    grid.sync();
    { PH_BEGIN; const float* mod1 = WSP(float, WS_MOD) + 16 * MODW; rows_ln<false>(q->out, WSP(float, WS_STATS), q->in[18] + 1 * D, q->in[19] + 1 * D, mod1 + 0 * D, mod1 + 1 * D, WSP(bf16_t, WS_U)); }
    grid.sync();
    { PH_BEGIN; EpiFoxIn E{WSP(bf16_t, WS_QF), WSP(bf16_t, WS_KF), WSP(bf16_t, WS_VT), WSP(float, WS_LOGF), q->in[11]}; run_gemm(L, WSP(bf16_t, WS_U), WSP(bf16_t, WS_WFIN), 3328, 1024, E); }
    grid.sync();
    { PH_BEGIN; phase_cumsum(WSP(float, WS_LOGF), WSP(float, WS_GNEG)); }
    grid.sync();
    { PH_BEGIN; attn_phase<64, 64, 16, false, true>(L, WSP(bf16_t, WS_QF), WSP(bf16_t, WS_KF), nullptr, WSP(bf16_t, WS_VT), WSP(float, WS_GNEG), WSP(bf16_t, WS_U)); }
    grid.sync();
    { PH_BEGIN; EpiRes<false> E{nullptr, q->out, WSP(float, WS_STATS), q->in[18] + 1 * D, q->in[19] + 1 * D, WSP(float, WS_MOD) + 16 * MODW + 2 * D}; run_gemm(L, WSP(bf16_t, WS_U), WSP(bf16_t, WS_WO1), 1024, 1024, E); }
    grid.sync();
    { PH_BEGIN; const float* mod1 = WSP(float, WS_MOD) + 16 * MODW; rows_ln<false>(q->out, WSP(float, WS_STATS), q->in[18] + 2 * D, q->in[19] + 2 * D, mod1 + 3 * D, mod1 + 4 * D, WSP(bf16_t, WS_U)); }
    grid.sync();
    { PH_BEGIN; EpiSwiGLU E{WSP(bf16_t, WS_H)}; run_gemm(L, WSP(bf16_t, WS_U), WSP(bf16_t, WS_WGU1), 2 * FF, 1024, E); }
    grid.sync();
    { PH_BEGIN; EpiRes<false> E{nullptr, q->out, WSP(float, WS_STATS), q->in[18] + 2 * D, q->in[19] + 2 * D, WSP(float, WS_MOD) + 16 * MODW + 5 * D}; run_gemm(L, WSP(bf16_t, WS_H), WSP(bf16_t, WS_WD1), 1024, FF, E); }
    grid.sync();
    { PH_BEGIN; rows_ln<true>(q->out, nullptr, q->in[18] + 3 * D, q->in[19] + 3 * D, nullptr, nullptr, nullptr); }
}

extern "C" void kernel_launch(void* const* d_in, const int* in_sizes, int n_in, void* d_out, int out_size, void* d_ws, size_t ws_size, hipStream_t stream) {
    static int grid = 0;
    if (grid == 0) {
        if (n_in != 20 || out_size != T * D || ws_size < WS_END) { fprintf(stderr, "kernel_launch: unexpected shapes (n_in %d out %d ws %zu)\n", n_in, out_size, ws_size); grid = -1; return; }
        int dev = 0, cus = 0, per_cu = 0;
        hipGetDevice(&dev); hipDeviceGetAttribute(&cus, hipDeviceAttributeMultiprocessorCount, dev);
        if (hipFuncSetAttribute((const void*)mk_fwd, hipFuncAttributeMaxDynamicSharedMemorySize, LDS_BYTES) != hipSuccess) { fprintf(stderr, "kernel_launch: hipFuncSetAttribute failed\n"); grid = -1; return; }
        hipOccupancyMaxActiveBlocksPerMultiprocessor(&per_cu, (const void*)mk_fwd, 512, LDS_BYTES);
        (void)hipGetLastError();
        if (per_cu < 1) per_cu = 1;
        grid = cus;
    }
    if (grid < 0) return;
    Params p{};
    for (int i = 0; i < 20; ++i) p.in[i] = (const float*)d_in[i];
    p.out = (float*)d_out; p.ws = (unsigned char*)d_ws;
    void* args[] = {&p};
    hipError_t e = hipLaunchCooperativeKernel((const void*)mk_fwd, dim3(grid), dim3(512), args, LDS_BYTES, stream);
    if (e != hipSuccess) fprintf(stderr, "cooperative launch failed: %s (grid %d)\n", hipGetErrorString(e), grid);
}
```

```cpp
#include <hip/hip_runtime.h>
#include <hip/hip_cooperative_groups.h>
#include <cstdio>
#include <cstdint>
namespace cg = cooperative_groups;
__device__ __forceinline__ int tid_opaque() { int t = threadIdx.x; asm volatile("" : "+v"(t)); return t; }
namespace pg8 {
#define PG8_LAS __attribute__((address_space(3)))
typedef unsigned short bf16_t;
typedef short bf16x8 __attribute__((ext_vector_type(8)));
typedef float f32x4 __attribute__((ext_vector_type(4)));
typedef unsigned u32x4 __attribute__((ext_vector_type(4)));
constexpr int BM = 256, BK = 64, HALF = 128, HTB = HALF * BK * 2  , STAGE_BYTES = 8 * HTB, NXCD = 8, WGM = 8;

__host__ __device__ __forceinline__ int lds_byte(int r, int c) { const int st = (r >> 4) * 2 + (c >> 5), rr = r & 15, cc = c & 31, ob = rr * 64 + cc * 2; return st * 1024 + (ob ^ (((ob >> 9) & 1) << 5)); }
__host__ __device__ __forceinline__ void stage_rc(int b, int& R, int& C) { const int st = b / 1024, sb = b % 1024, swz = sb ^ (((sb >> 9) & 1) << 5); R = (st >> 1) * 16 + swz / 64; C = (st & 1) * 32 + (swz % 64) / 2; }
__host__ __device__ __forceinline__ int perm32(int rho) { const int n = rho >> 4, i = rho & 15; return 8 * (i >> 2) + 4 * n + (i & 3); }

struct Unit { int pm, pn; };
struct Gemm { const bf16_t* A; const bf16_t* Bt; int M, N, K; };

struct StaticOrder {
    int nM, nN, nwg, G, c;
    __host__ __device__ void init(int M, int N, int G_, int c_) { nM = M / BM; nN = N / BM; nwg = nM * nN; G = G_; c = c_; }
    __host__ __device__ bool next(int i, Unit& u) const {
        const long L = (long)i * G + c; if (L >= nwg) return false;
        int wgid = (int)L; { const int q = nwg / NXCD, r = nwg % NXCD, xcd = wgid % NXCD, off = wgid / NXCD; wgid = (xcd < r ? xcd * (q + 1) : r * (q + 1) + (xcd - r) * q) + off; }
        const int nig = WGM * nN, gid = wgid / nig, fm = gid * WGM, gsz = (nM - fm) < WGM ? (nM - fm) : WGM;
        u.pm = fm + ((wgid % nig) % gsz); u.pn = (wgid % nig) / gsz; return true;
    }
    __device__ __forceinline__ void a_ready(const Unit&) const {}
    __device__ __forceinline__ void done(const Unit&) const {}
};
template <class Epi, class Sched, bool ALIGN_EPI = false, bool SP2 = false>
__device__ __forceinline__ void gemm_phase(PG8_LAS unsigned char* lds, const Gemm g, const Sched& S, const Epi& E) {
    const int tid = tid_opaque(), wid = __builtin_amdgcn_readfirstlane(tid >> 6), lane = tid & 63, wr = wid >> 2, wc = wid & 3, fr = lane & 15, fq = lane >> 4;
    const int K = g.K, nt = K / BK;
    unsigned voffA[2], voffB[2];
#pragma unroll
    for (int i = 0; i < 2; ++i) { int R, C; stage_rc(tid * 16 + i * 8192, R, C); const int Rb = Epi::PERM ? ((R & ~31) + perm32(R & 31)) : R;
        voffA[i] = (unsigned)(R * K + C) * 2u; voffB[i] = (unsigned)(Rb * K + C) * 2u; }
    const size_t kstep = (size_t)(BK * 2);
    const size_t hstep = (size_t)HALF * K * 2;
    const size_t tstep = 2 * hstep;
    const unsigned ldsw = (unsigned)wid * 1024u;
    const int aoff = lds_byte(wr * 64 + fr, fq * 8), boff = lds_byte(wc * 32 + fr, fq * 8);
#define PG8_SA(b, h) (((b) * 2 + (h)) * HTB)
#define PG8_SB(b, h) ((4 + (b) * 2 + (h)) * HTB)
#define PG8_STAGE(bufoff, gbase, voff) do { _Pragma("unroll") for (int _i = 0; _i < 2; ++_i) \
        __builtin_amdgcn_global_load_lds((const unsigned*)((const char*)(gbase) + (voff)[_i]), (PG8_LAS unsigned*)(lds + (bufoff) + ldsw + _i * 8192), 16, 0, 0); } while (0)
#define PG8_LDA(dst, b, h) do { _Pragma("unroll") for (int m = 0; m < 4; ++m) _Pragma("unroll") for (int k = 0; k < 2; ++k) dst[m][k] = *(const PG8_LAS bf16x8*)(lds + PG8_SA(b, h) + aoff + m * 2048 + k * 1024); } while (0)
#define PG8_LDB(dst, b, h) do { _Pragma("unroll") for (int n = 0; n < 2; ++n) _Pragma("unroll") for (int k = 0; k < 2; ++k) dst[n][k] = *(const PG8_LAS bf16x8*)(lds + PG8_SB(b, h) + boff + n * 2048 + k * 1024); } while (0)
#define PG8_MMA(ai, bj, At, Bt) do { __builtin_amdgcn_s_setprio(1); _Pragma("unroll") for (int m = 0; m < 4; ++m) _Pragma("unroll") for (int n = 0; n < 2; ++n) _Pragma("unroll") for (int k = 0; k < 2; ++k) \
        acc[ai][bj][m][n] = __builtin_amdgcn_mfma_f32_16x16x32_bf16(Bt[n][k], At[m][k], acc[ai][bj][m][n], 0, 0, 0); __builtin_amdgcn_s_setprio(0); } while (0)
#define PG8_WAIT_V(n) asm volatile("s_waitcnt vmcnt(" #n ")" ::: "memory")
#define PG8_WAIT_L(n) asm volatile("s_waitcnt lgkmcnt(" #n ")" ::: "memory")
#define PG8_BAR __builtin_amdgcn_s_barrier()
#define PG8_SCHED __builtin_amdgcn_sched_barrier(0)
    Unit cur, nxt; int ui = 0;
    if (!S.next(0, cur)) return;
    f32x4 acc[2][2][4][2];
#pragma unroll
    for (int a = 0; a < 2; ++a)
#pragma unroll
        for (int b = 0; b < 2; ++b)
#pragma unroll
            for (int m = 0; m < 4; ++m)
#pragma unroll
                for (int n = 0; n < 2; ++n) acc[a][b][m][n] = (f32x4){0.f, 0.f, 0.f, 0.f};
    bf16x8 At[4][2], B0[2][2], B1[2][2];
    const char* cA = (const char*)g.A + (size_t)cur.pm * tstep; const char* cB = (const char*)g.Bt + (size_t)cur.pn * tstep;
    S.a_ready(cur);
    if constexpr (SP2) {
        PG8_STAGE(PG8_SB(0, 0), cB, voffB); PG8_STAGE(PG8_SB(0, 1), cB + hstep, voffB); PG8_STAGE(PG8_SA(0, 0), cA, voffA); PG8_STAGE(PG8_SA(0, 1), cA + hstep, voffA);
        if (wr == 1) PG8_BAR;
        PG8_WAIT_V(2); PG8_BAR;
        PG8_STAGE(PG8_SB(1, 0), cB + kstep, voffB); PG8_STAGE(PG8_SA(1, 0), cA + kstep, voffA); PG8_STAGE(PG8_SB(1, 1), cB + hstep + kstep, voffB);
        PG8_WAIT_V(6); PG8_BAR;
    } else {
        PG8_STAGE(PG8_SB(0, 0), cB, voffB); PG8_STAGE(PG8_SA(0, 0), cA, voffA); PG8_STAGE(PG8_SB(0, 1), cB + hstep, voffB); PG8_STAGE(PG8_SA(0, 1), cA + hstep, voffA);
        if (wr == 1) PG8_BAR;
        PG8_WAIT_V(4); PG8_BAR;
        PG8_STAGE(PG8_SB(1, 0), cB + kstep, voffB); PG8_STAGE(PG8_SA(1, 0), cA + kstep, voffA); PG8_STAGE(PG8_SB(1, 1), cB + hstep + kstep, voffB);
        PG8_WAIT_V(6); PG8_BAR;
    }
    for (;;) {
        const bool has_next = S.next(ui + 1, nxt);
        const char* nA = has_next ? (const char*)g.A + (size_t)nxt.pm * tstep : cA; const char* nB = has_next ? (const char*)g.Bt + (size_t)nxt.pn * tstep : cB;
#pragma nounroll
        for (int t = 0; t < nt; t += 2) {
            const bool last = (t == nt - 2);
            const char* a1 = cA + (size_t)(t + 1) * kstep;
            const char* a2 = last ? nA : cA + (size_t)(t + 2) * kstep; const char* b2 = last ? nB : cB + (size_t)(t + 2) * kstep;
            const char* a3 = a2 + kstep; const char* b3 = b2 + kstep;
            if (last && has_next) S.a_ready(nxt);
            if constexpr (SP2) {
            PG8_LDB(B0, 0, 0); PG8_LDB(B1, 0, 1); PG8_SCHED; PG8_LDA(At, 0, 0); PG8_STAGE(PG8_SA(1, 1), a1 + hstep, voffA);
            PG8_WAIT_V(8); PG8_WAIT_L(0); PG8_BAR; PG8_MMA(0, 0, At, B0); PG8_MMA(0, 1, At, B1); PG8_BAR; PG8_SCHED;
            PG8_LDA(At, 0, 1); PG8_STAGE(PG8_SB(0, 0), b2, voffB); PG8_STAGE(PG8_SB(0, 1), b2 + hstep, voffB); PG8_STAGE(PG8_SA(0, 0), a2, voffA);
            PG8_WAIT_V(8); PG8_WAIT_L(0); PG8_BAR; PG8_MMA(1, 0, At, B0); PG8_MMA(1, 1, At, B1); PG8_BAR; PG8_SCHED;
            PG8_LDB(B0, 1, 0); PG8_LDB(B1, 1, 1); PG8_SCHED; PG8_LDA(At, 1, 0); PG8_STAGE(PG8_SA(0, 1), a2 + hstep, voffA);
            PG8_WAIT_V(8); PG8_WAIT_L(0); PG8_BAR; PG8_MMA(0, 0, At, B0); PG8_MMA(0, 1, At, B1); PG8_BAR; PG8_SCHED;
            PG8_LDA(At, 1, 1); PG8_STAGE(PG8_SB(1, 0), b3, voffB); PG8_STAGE(PG8_SB(1, 1), b3 + hstep, voffB); PG8_STAGE(PG8_SA(1, 0), a3, voffA);
            PG8_WAIT_V(8); PG8_WAIT_L(0); PG8_BAR; PG8_MMA(1, 0, At, B0); PG8_MMA(1, 1, At, B1); PG8_BAR; PG8_SCHED;
            } else {
            PG8_LDB(B0, 0, 0); PG8_SCHED; PG8_LDA(At, 0, 0); PG8_STAGE(PG8_SA(1, 1), a1 + hstep, voffA);
            PG8_WAIT_L(8); PG8_BAR; PG8_WAIT_L(0); PG8_MMA(0, 0, At, B0); PG8_BAR; PG8_SCHED;
            PG8_LDB(B1, 0, 1); PG8_STAGE(PG8_SB(0, 0), b2, voffB);
            PG8_BAR; PG8_WAIT_L(0); PG8_MMA(0, 1, At, B1); PG8_BAR;
            PG8_LDA(At, 0, 1); PG8_STAGE(PG8_SA(0, 0), a2, voffA);
            PG8_BAR; PG8_WAIT_L(0); PG8_MMA(1, 0, At, B0); PG8_BAR; PG8_SCHED;
            PG8_STAGE(PG8_SB(0, 1), b2 + hstep, voffB);
            PG8_WAIT_V(6); PG8_BAR; PG8_MMA(1, 1, At, B1); PG8_BAR;
            PG8_LDB(B0, 1, 0); PG8_SCHED; PG8_LDA(At, 1, 0); PG8_STAGE(PG8_SA(0, 1), a2 + hstep, voffA);
            PG8_WAIT_L(8); PG8_BAR; PG8_WAIT_L(0); PG8_MMA(0, 0, At, B0); PG8_BAR; PG8_SCHED;
            PG8_LDB(B1, 1, 1); PG8_STAGE(PG8_SB(1, 0), b3, voffB);
            PG8_BAR; PG8_WAIT_L(0); PG8_MMA(0, 1, At, B1); PG8_BAR;
            PG8_LDA(At, 1, 1); PG8_STAGE(PG8_SA(1, 0), a3, voffA);
            PG8_BAR; PG8_WAIT_L(0); PG8_MMA(1, 0, At, B0); PG8_BAR; PG8_SCHED;
            PG8_STAGE(PG8_SB(1, 1), b3 + hstep, voffB);
            PG8_WAIT_V(6); PG8_BAR; PG8_MMA(1, 1, At, B1); PG8_BAR;
            }
        }
        if constexpr (ALIGN_EPI) { if (wr == 0) PG8_BAR; }
        if constexpr (!Epi::AFTER_DRAIN) { E(acc, cur, wr, wc, fr, fq); S.done(cur); }
        if (!has_next) break;
#pragma unroll
        for (int a = 0; a < 2; ++a)
#pragma unroll
            for (int b = 0; b < 2; ++b)
#pragma unroll
                for (int m = 0; m < 4; ++m)
#pragma unroll
                    for (int n = 0; n < 2; ++n) acc[a][b][m][n] = (f32x4){0.f, 0.f, 0.f, 0.f};
        cur = nxt; cA = nA; cB = nB; ++ui;
        if constexpr (ALIGN_EPI) { if (wr == 1) PG8_BAR; }
    }
    PG8_WAIT_V(0);
    if constexpr (!ALIGN_EPI) { if (wr == 0) PG8_BAR; }
    PG8_BAR;
    if constexpr (Epi::AFTER_DRAIN) { E.fused(acc, cur, wr, wc, fr, fq, lds, wid, lane); S.done(cur); }
#undef PG8_SA
#undef PG8_SB
#undef PG8_STAGE
#undef PG8_LDA
#undef PG8_LDB
#undef PG8_MMA
#undef PG8_WAIT_V
#undef PG8_WAIT_L
#undef PG8_BAR
#undef PG8_SCHED
}
}
#define LAS __attribute__((address_space(3)))
using pg8::bf16_t; using pg8::bf16x8; using pg8::f32x4; using pg8::u32x4;
typedef float f32x16 __attribute__((ext_vector_type(16)));
typedef unsigned u32x2 __attribute__((ext_vector_type(2)));
typedef float f32x2 __attribute__((ext_vector_type(2)));

constexpr int T = 32768, D = 1024, NB = 16, SEQ = 2048, FF = 2816;
constexpr float ALPHA = 1.4142135623730951f;
constexpr float EPS = 1e-5f;
constexpr float LOG2E = 1.4426950408889634f;
constexpr float C2_MLA = 0.07216878364870323f * LOG2E;
constexpr float C2_FOX = 0.125f * LOG2E;
constexpr int MODW = 6 * D;

constexpr size_t MiB = 1u << 20;
constexpr size_t WS_WIN0 = 0, WS_WUQ = 2 * MiB, WS_WUKV = 3 * MiB, WS_WO0 = 4 * MiB, WS_WFIN = 6 * MiB, WS_WO1 = 13 * MiB;
constexpr size_t WS_WGU0 = 15 * MiB, WS_WGU1 = 26 * MiB, WS_WD0 = 37 * MiB, WS_WD1 = 43 * MiB;
constexpr size_t WS_MOD = 49 * MiB, WS_STATS = 50 * MiB, WS_SSQ = 51 * MiB, WS_LOGF = 52 * MiB, WS_GNEG = 54 * MiB, WS_CS = 56 * MiB;
constexpr size_t WS_U = 64 * MiB, WS_HQ = 128 * MiB, WS_HKV = 144 * MiB, WS_KROPE = 160 * MiB;
constexpr size_t WS_BIG = 164 * MiB;
constexpr size_t WS_Q = WS_BIG, WS_KNOPE = WS_BIG + 96 * MiB, WS_VT = WS_BIG + 160 * MiB;
constexpr size_t WS_QF = WS_BIG, WS_KF = WS_BIG + 64 * MiB;
constexpr size_t WS_H = WS_BIG;
constexpr size_t WS_END = WS_BIG + 224 * MiB;
constexpr size_t WS_BAR = WS_END, WS_END2 = WS_END + 1 * MiB;

constexpr int LDS_BYTES = 147456;

__device__ __forceinline__ unsigned cvt_pk_bf16(float lo, float hi) { unsigned r; asm volatile("v_cvt_pk_bf16_f32 %0, %1, %2" : "=v"(r) : "v"(lo), "v"(hi)); return r; }
__device__ __forceinline__ u32x2 pack4(f32x4 v) { u32x2 w; w.x = cvt_pk_bf16(v[0], v[1]); w.y = cvt_pk_bf16(v[2], v[3]); return w; }
__device__ __forceinline__ float wave_sum(float v) {
#pragma unroll
    for (int o = 1; o < 64; o <<= 1) v += __shfl_xor(v, o);
    return v;
}

struct Params { const float* in[20]; float* out; unsigned char* ws; };


struct EpiMlaIn {
    static constexpr bool PERM = false, AFTER_DRAIN = false;
    bf16_t* hq; bf16_t* hkv; bf16_t* krope; float* ssq; const float* cs;
    __device__ __forceinline__ void operator()(const f32x4 (&acc)[2][2][4][2], const pg8::Unit& u, int wr, int wc, int fr, int fq) const {
        if (u.pn < 2) {
            bf16_t* dst = u.pn == 0 ? hq : hkv;
#pragma unroll
            for (int ai = 0; ai < 2; ++ai)
#pragma unroll
                for (int m = 0; m < 4; ++m) {
                    const int row = u.pm * 256 + ai * 128 + wr * 64 + m * 16 + fr; float s = 0.f;
#pragma unroll
                    for (int bj = 0; bj < 2; ++bj)
#pragma unroll
                        for (int n = 0; n < 2; ++n) { const f32x4 v = acc[ai][bj][m][n]; s += (v[0] * v[0] + v[1] * v[1]) + (v[2] * v[2] + v[3] * v[3]);
                            *(u32x2*)(dst + (size_t)row * 256 + bj * 128 + wc * 32 + n * 16 + fq * 4) = pack4(v); }
                    s += __shfl_xor(s, 16); s += __shfl_xor(s, 32);
                    if (fq == 0) ssq[((size_t)row * 2 + u.pn) * 4 + wc] = s; asm volatile("" ::: "memory");
                }
        } else if (wc < 2) {
            const int i0 = 16 * wc + 4 * fq;
#pragma unroll
            for (int ai = 0; ai < 2; ++ai)
#pragma unroll
                for (int m = 0; m < 4; ++m) {
                    const int row = u.pm * 256 + ai * 128 + wr * 64 + m * 16 + fr;
                    const f32x4 x1 = acc[ai][0][m][0], x2 = acc[ai][0][m][1];
                    const f32x4 ca = *(const f32x4*)(cs + ((size_t)row * 32 + i0) * 2), cb = *(const f32x4*)(cs + ((size_t)row * 32 + i0) * 2 + 4);
                    const f32x4 c = {ca[0], ca[2], cb[0], cb[2]}, sn = {ca[1], ca[3], cb[1], cb[3]};
                    const f32x4 o1 = x1 * c - x2 * sn, o2 = x2 * c + x1 * sn;
                    *(u32x2*)(krope + (size_t)row * 64 + i0) = pack4(o1);
                    *(u32x2*)(krope + (size_t)row * 64 + 32 + i0) = pack4(o2); asm volatile("" ::: "memory");
                }
        }
    }
};

struct EpiQ {
    static constexpr bool PERM = false, AFTER_DRAIN = false;
    bf16_t* Q; const float* ssq; const float* cs;
    __device__ __forceinline__ void operator()(const f32x4 (&acc)[2][2][4][2], const pg8::Unit& u, int wr, int wc, int fr, int fq) const {
#pragma unroll
        for (int ai = 0; ai < 2; ++ai)
#pragma unroll
            for (int m = 0; m < 4; ++m) {
                const int row = u.pm * 256 + ai * 128 + wr * 64 + m * 16 + fr;
                const f32x4 sp = *(const f32x4*)(ssq + ((size_t)row * 2 + 0) * 4);
                const float rs = C2_MLA / sqrtf(((sp[0] + sp[1]) + (sp[2] + sp[3])) * (1.f / 256.f) + EPS);
#pragma unroll
                for (int bj = 0; bj < 2; ++bj) {
                    const int c32 = u.pn * 256 + bj * 128 + wc * 32, h = c32 / 192, w32 = c32 - h * 192;
                    if (w32 < 128) {
#pragma unroll
                        for (int n = 0; n < 2; ++n) *(u32x2*)(Q + (size_t)row * 1536 + c32 + n * 16 + fq * 4) = pack4(acc[ai][bj][m][n] * rs);
                    } else {
                        const int i0 = 16 * ((w32 - 128) >> 5) + 4 * fq;
                        const f32x4 x1 = acc[ai][bj][m][0] * rs, x2 = acc[ai][bj][m][1] * rs;
                        const f32x4 ca = *(const f32x4*)(cs + ((size_t)row * 32 + i0) * 2), cb = *(const f32x4*)(cs + ((size_t)row * 32 + i0) * 2 + 4);
                        const f32x4 c = {ca[0], ca[2], cb[0], cb[2]}, sn = {ca[1], ca[3], cb[1], cb[3]};
                        const f32x4 o1 = x1 * c - x2 * sn, o2 = x2 * c + x1 * sn;
                        *(u32x2*)(Q + (size_t)row * 1536 + h * 192 + 128 + i0) = pack4(o1);
                        *(u32x2*)(Q + (size_t)row * 1536 + h * 192 + 128 + 32 + i0) = pack4(o2);
                    }
                }
                asm volatile("" ::: "memory");
            }
    }
};

struct EpiKV {
    static constexpr bool PERM = false, AFTER_DRAIN = false;
    bf16_t* Kn; bf16_t* Vt; const float* ssq;
    __device__ __forceinline__ void operator()(const f32x4 (&acc)[2][2][4][2], const pg8::Unit& u, int wr, int wc, int fr, int fq) const {
#pragma unroll
        for (int ai = 0; ai < 2; ++ai)
#pragma unroll
            for (int m = 0; m < 4; ++m) {
                const int row = u.pm * 256 + ai * 128 + wr * 64 + m * 16 + fr;
                const f32x4 sp = *(const f32x4*)(ssq + ((size_t)row * 2 + 1) * 4);
                const float rs = 1.f / sqrtf(((sp[0] + sp[1]) + (sp[2] + sp[3])) * (1.f / 256.f) + EPS);
                const int b = row >> 11, s = row & 2047;
#pragma unroll
                for (int bj = 0; bj < 2; ++bj)
#pragma unroll
                    for (int n = 0; n < 2; ++n) {
                        const int col = u.pn * 256 + bj * 128 + wc * 32 + n * 16 + fq * 4; const f32x4 v = acc[ai][bj][m][n] * rs;
                        if (u.pn < 4) *(u32x2*)(Kn + (size_t)row * 1024 + col) = pack4(v);
                        else { const u32x2 w = pack4(v); const int vc = col - 1024;
                            bf16_t* p = Vt + ((size_t)b * 1024 + vc) * 2048 + s;
                            p[0] = (bf16_t)(w.x & 0xffffu); p[2048] = (bf16_t)(w.x >> 16); p[4096] = (bf16_t)(w.y & 0xffffu); p[6144] = (bf16_t)(w.y >> 16); }
                    }
                asm volatile("" ::: "memory");
            }
    }
};

struct EpiFoxIn {
    static constexpr bool PERM = false, AFTER_DRAIN = false;
    bf16_t* Qf; bf16_t* Kf; bf16_t* Vt; float* logf; const float* bf;
    __device__ __forceinline__ void operator()(const f32x4 (&acc)[2][2][4][2], const pg8::Unit& u, int wr, int wc, int fr, int fq) const {
#pragma unroll
        for (int ai = 0; ai < 2; ++ai)
#pragma unroll
            for (int m = 0; m < 4; ++m) {
                const int row = u.pm * 256 + ai * 128 + wr * 64 + m * 16 + fr;
                const int b = row >> 11, s = row & 2047;
                if (u.pn == 12) {
                    if (wc == 0) { const f32x4 v = acc[ai][0][m][0]; const f32x4 bb = *(const f32x4*)(bf + 4 * fq); f32x4 o;
#pragma unroll
                        for (int e = 0; e < 4; ++e) { const float x = v[e] + bb[e]; o[e] = fminf(x, 0.f) - log1pf(__expf(-fabsf(x))); }
                        *(f32x4*)(logf + (size_t)row * 16 + 4 * fq) = o; }
                } else {
#pragma unroll
                    for (int bj = 0; bj < 2; ++bj)
#pragma unroll
                        for (int n = 0; n < 2; ++n) {
                            const int col = u.pn * 256 + bj * 128 + wc * 32 + n * 16 + fq * 4; const f32x4 v = acc[ai][bj][m][n];
                            if (u.pn < 4) *(u32x2*)(Qf + (size_t)row * 1024 + col) = pack4(v * C2_FOX);
                            else if (u.pn < 8) *(u32x2*)(Kf + (size_t)row * 1024 + col - 1024) = pack4(v);
                            else { const u32x2 w = pack4(v); const int vc = col - 2048;
                                bf16_t* p = Vt + ((size_t)b * 1024 + vc) * 2048 + s;
                                p[0] = (bf16_t)(w.x & 0xffffu); p[2048] = (bf16_t)(w.x >> 16); p[4096] = (bf16_t)(w.y & 0xffffu); p[6144] = (bf16_t)(w.y >> 16); }
                        }
                }
                asm volatile("" ::: "memory");
            }
    }
};

template <bool FIRST> struct EpiRes {
    static constexpr bool PERM = false, AFTER_DRAIN = false;
    const float* xin; float* z; const float* stats; const float* lng; const float* lnb; const float* gate;
    __device__ __forceinline__ void operator()(const f32x4 (&acc)[2][2][4][2], const pg8::Unit& u, int wr, int wc, int fr, int fq) const {
        const int b = (u.pm * 256) >> 11;
#pragma unroll
        for (int bj = 0; bj < 2; ++bj)
#pragma unroll
            for (int n = 0; n < 2; ++n) {
                const int col = u.pn * 256 + bj * 128 + wc * 32 + n * 16 + fq * 4;
                const f32x4 gt = *(const f32x4*)(gate + (size_t)b * MODW + col) + 1.0f;
                f32x4 g = {0.f, 0.f, 0.f, 0.f}, bb = {0.f, 0.f, 0.f, 0.f};
                if (!FIRST) { g = *(const f32x4*)(lng + col); bb = *(const f32x4*)(lnb + col); }
#pragma unroll
                for (int ai = 0; ai < 2; ++ai)
#pragma unroll
                    for (int m = 0; m < 4; ++m) {
                        const int row = u.pm * 256 + ai * 128 + wr * 64 + m * 16 + fr; const size_t off = (size_t)row * 1024 + col;
                        f32x4 x;
                        if (FIRST) x = *(const f32x4*)(xin + off);
                        else { const f32x2 st = *(const f32x2*)(stats + (size_t)row * 2); x = (*(const f32x4*)(z + off) - st.x) * st.y * g + bb; }
                        *(f32x4*)(z + off) = x * ALPHA + gt * acc[ai][bj][m][n];
                        if (m & 1) asm volatile("" ::: "memory");
                    }
            }
    }
};

struct EpiSwiGLU {
    static constexpr bool PERM = false, AFTER_DRAIN = false;
    bf16_t* H;
    __device__ __forceinline__ void operator()(const f32x4 (&acc)[2][2][4][2], const pg8::Unit& u, int wr, int wc, int fr, int fq) const {
#pragma unroll
        for (int ai = 0; ai < 2; ++ai)
#pragma unroll
            for (int m = 0; m < 4; ++m) {
                const int row = u.pm * 256 + ai * 128 + wr * 64 + m * 16 + fr;
#pragma unroll
                for (int bj = 0; bj < 2; ++bj) {
                    const int hc = (u.pn * 256 + bj * 128 + wc * 32) / 2 + 4 * fq;
                    const f32x4 g = acc[ai][bj][m][0], up = acc[ai][bj][m][1]; f32x4 o;
#pragma unroll
                    for (int e = 0; e < 4; ++e) o[e] = g[e] * up[e] * __builtin_amdgcn_rcpf(1.f + __builtin_amdgcn_exp2f(-g[e] * LOG2E));
                    *(u32x2*)(H + (size_t)row * FF + hc) = pack4(o);
                }
            }
    }
};
#define XB_TMO      128
#define XB_XCNT(j)  (256  + 64 * (j))
#define XB_XSUB(j)  (1280 + 64 * (j))
#define XB_XGEN(j)  (2304 + 64 * (j))
#define XB_TOP      3328
#define XB_TOPGEN   3392
#define XCD_BAR_WORDS 3456
#define XB_SPIN_CAP (1u << 18)

__device__ __forceinline__ unsigned xb_ld(unsigned* p)              { return __hip_atomic_load(p, __ATOMIC_RELAXED, __HIP_MEMORY_SCOPE_AGENT); }
__device__ __forceinline__ unsigned xb_add(unsigned* p, unsigned v) { return __hip_atomic_fetch_add(p, v, __ATOMIC_RELAXED, __HIP_MEMORY_SCOPE_AGENT); }
__device__ __forceinline__ unsigned xb_xcc_id() { return (unsigned)__builtin_amdgcn_s_getreg((3 << 11) | 20) & 0xFu; }
#define XB_SPIN(cond, bar) do { unsigned _sp = 0; while (cond) { __builtin_amdgcn_s_sleep(1); \
    if ((++_sp & 255u) == 0u) { if (xb_ld(&(bar)[XB_TMO])) break; if (_sp > XB_SPIN_CAP) { atomicAdd(&(bar)[XB_TMO], 1u); break; } } } } while (0)

struct XcdBarrier {
    unsigned* bar; unsigned x;
    volatile LAS unsigned* st;
};

__device__ __forceinline__ XcdBarrier xcd_barrier_post(unsigned* bar, volatile LAS unsigned* st) {
    XcdBarrier b; b.bar = bar; b.x = xb_xcc_id(); b.st = st;
    if (threadIdx.x == 0) (void)xb_add(&bar[XB_XCNT(b.x)], 1u);
    return b;
}
__device__ __forceinline__ void xcd_barrier_complete(unsigned* bar, unsigned x, unsigned& nloc, unsigned& nx) {
    const unsigned G = gridDim.x * gridDim.y * gridDim.z;
    unsigned sum, cnt, mine, sp = 0u;
    for (;;) {
        sum = 0u; cnt = 0u; mine = 0u;
#pragma unroll
        for (unsigned j = 0; j < 16; ++j) { const unsigned c = xb_ld(&bar[XB_XCNT(j)]); sum += c; cnt += (c > 0u) ? 1u : 0u; mine = (j == x) ? c : mine; }
        if (sum == G) break;
        __builtin_amdgcn_s_sleep(1);
        if ((++sp & 255u) == 0u) { if (xb_ld(&bar[XB_TMO])) break; if (sp > XB_SPIN_CAP) { atomicAdd(&bar[XB_TMO], 1u); break; } }
    }
    nloc = mine > 0u ? mine : 1u; nx = cnt > 0u ? cnt : 1u;
}

__device__ __forceinline__ void xcd_barrier(const XcdBarrier& b) {
    asm volatile("s_waitcnt vmcnt(0)" ::: "memory");
    __syncthreads();
    if (threadIdx.x == 0) {
        unsigned* bar = b.bar;
        __builtin_amdgcn_s_waitcnt(0);
        unsigned nloc = b.st[0], nx = b.st[1];
        if (nloc == 0u) { xcd_barrier_complete(bar, b.x, nloc, nx); b.st[0] = nloc; b.st[1] = nx; }
        const unsigned old = xb_add(&bar[XB_XSUB(b.x)], 1u);
        const unsigned gen = old / nloc;
        if (old + 1u == (gen + 1u) * nloc) {
            __builtin_amdgcn_fence(__ATOMIC_RELEASE, "agent");
            asm volatile("s_waitcnt vmcnt(0)" ::: "memory");
            const unsigned og = xb_add(&bar[XB_TOP], 1u);
            const unsigned tg = og / nx;
            if (og + 1u == (tg + 1u) * nx) xb_add(&bar[XB_TOPGEN], 1u);
            else XB_SPIN(xb_ld(&bar[XB_TOPGEN]) == tg, bar);
            __builtin_amdgcn_fence(__ATOMIC_ACQUIRE, "agent");
            xb_add(&bar[XB_XGEN(b.x)], 1u);
            asm volatile("s_waitcnt vmcnt(0)" ::: "memory");
        } else {
            XB_SPIN(xb_ld(&bar[XB_XGEN(b.x)]) == gen, bar);
            __builtin_amdgcn_fence(__ATOMIC_ACQUIRE, "agent");
            asm volatile("s_waitcnt vmcnt(0)" ::: "memory");
        }
    }
    __syncthreads();
}

enum { MAP_ID = 0, MAP_MLAIN = 1, MAP_UQ = 2, MAP_GU = 3 };
struct TrJob { const float* src0; long delta; const float* kscale; bf16_t* dst; int ldw, K, Npad, nvalid, map; };
__device__ __forceinline__ int map_col(int map, int j, int nvalid, int& which) {
    which = 0;
    if (map == MAP_ID) return j < nvalid ? j : -1;
    if (map == MAP_MLAIN) { if (j < 512) return j; if (j >= 576) return -1; const int jj = j - 512, g2 = jj >> 5, r = jj & 31; return 512 + 16 * g2 + (r & 15) + 32 * (r >> 4); }
    if (map == MAP_UQ) { const int h = j / 192, w = j - h * 192; if (w < 128) return j; const int jj = w - 128, g2 = jj >> 5, r = jj & 31; return h * 192 + 128 + 16 * g2 + (r & 15) + 32 * (r >> 4); }
    { const int g32 = j >> 5, r = j & 31; which = r >> 4; return 16 * g32 + (r & 15); }
}
__device__ __forceinline__ void tr_item(const TrJob& J, LAS float* scr, int item, int lane) {
    const int nblk = J.Npad / 32, kb = item / nblk, nb = item - kb * nblk, k0 = 64 * kb, n0 = 32 * nb;
    int which; const int sc = map_col(J.map, n0 + (lane & 31), J.nvalid, which);
    const float* W = J.src0 + (which ? J.delta : 0L);
#pragma unroll 8
    for (int i = 0; i < 32; ++i) { const int kk = 2 * i + (lane >> 5); float v = 0.f;
        if (sc >= 0) { v = W[(size_t)(k0 + kk) * J.ldw + sc]; if (J.kscale) v *= J.kscale[k0 + kk]; }
        scr[kk * 33 + (lane & 31)] = v; }
    asm volatile("s_waitcnt lgkmcnt(0)" ::: "memory");
    const int c = lane & 7;
#pragma unroll
    for (int j = 0; j < 4; ++j) { const int n = (lane >> 3) + 8 * j; const LAS float* s = scr + (8 * c) * 33 + n;
        u32x4 o; o.x = cvt_pk_bf16(s[0 * 33], s[1 * 33]); o.y = cvt_pk_bf16(s[2 * 33], s[3 * 33]); o.z = cvt_pk_bf16(s[4 * 33], s[5 * 33]); o.w = cvt_pk_bf16(s[6 * 33], s[7 * 33]);
        *(u32x4*)(J.dst + (size_t)(n0 + n) * J.K + k0 + 8 * c) = o; }
    asm volatile("s_waitcnt lgkmcnt(0)" ::: "memory");
}
constexpr int N_TRJOBS = 11;
__device__ __forceinline__ TrJob get_job(const Params& P, int id) {
    unsigned char* ws = P.ws; TrJob J; J.delta = 0; J.kscale = nullptr; J.map = MAP_ID;
    switch (id) {
    case 0: J.src0 = P.in[3]; J.dst = (bf16_t*)(ws + WS_WIN0); J.ldw = 576; J.K = 1024; J.Npad = 768; J.nvalid = 576; J.map = MAP_MLAIN; break;
    case 1: J.src0 = P.in[5]; J.kscale = P.in[4]; J.dst = (bf16_t*)(ws + WS_WUQ); J.ldw = 1536; J.K = 256; J.Npad = 1536; J.nvalid = 1536; J.map = MAP_UQ; break;
    case 2: J.src0 = P.in[7]; J.kscale = P.in[6]; J.dst = (bf16_t*)(ws + WS_WUKV); J.ldw = 1024; J.K = 256; J.Npad = 1024; J.nvalid = 1024; break;
    case 3: J.src0 = P.in[8]; J.kscale = P.in[6]; J.dst = (bf16_t*)(ws + WS_WUKV) + 1024 * 256; J.ldw = 1024; J.K = 256; J.Npad = 1024; J.nvalid = 1024; break;
    case 4: J.src0 = P.in[9]; J.dst = (bf16_t*)(ws + WS_WO0); J.ldw = 1024; J.K = 1024; J.Npad = 1024; J.nvalid = 1024; break;
    case 5: J.src0 = P.in[10]; J.dst = (bf16_t*)(ws + WS_WFIN); J.ldw = 3088; J.K = 1024; J.Npad = 3328; J.nvalid = 3088; break;
    case 6: J.src0 = P.in[12]; J.dst = (bf16_t*)(ws + WS_WO1); J.ldw = 1024; J.K = 1024; J.Npad = 1024; J.nvalid = 1024; break;
    case 7: J.src0 = P.in[15]; J.delta = (long)(P.in[16] - P.in[15]); J.dst = (bf16_t*)(ws + WS_WGU0); J.ldw = FF; J.K = 1024; J.Npad = 2 * FF; J.nvalid = 2 * FF; J.map = MAP_GU; break;
    case 8: J.src0 = P.in[15] + (size_t)D * FF; J.delta = (long)(P.in[16] - P.in[15]); J.dst = (bf16_t*)(ws + WS_WGU1); J.ldw = FF; J.K = 1024; J.Npad = 2 * FF; J.nvalid = 2 * FF; J.map = MAP_GU; break;
    case 9: J.src0 = P.in[17]; J.dst = (bf16_t*)(ws + WS_WD0); J.ldw = 1024; J.K = FF; J.Npad = 1024; J.nvalid = 1024; break;
    default: J.src0 = P.in[17] + (size_t)FF * D; J.dst = (bf16_t*)(ws + WS_WD1); J.ldw = 1024; J.K = FF; J.Npad = 1024; J.nvalid = 1024; break;
    }
    return J;
}
__device__ __forceinline__ void adaln_item(LAS float* lds, const Params& P, int item) {
    const int tid = tid_opaque(), lane = tid & 63, w = tid >> 6;
    const int i = item / 96, cg0 = (item - i * 96) * 64;
    const float* c = P.in[1]; const float* aw = P.in[13] + (size_t)i * D * MODW; const float* ab = P.in[14] + (size_t)i * MODW;
    float* mod = (float*)(P.ws + WS_MOD) + (size_t)i * 16 * MODW;
    for (int e = tid; e < 16 * 1024; e += 512) { const int b = e >> 10, k = e & 1023; const float v = c[e]; lds[k * 16 + b] = v / (1.f + __expf(-v)); }
    __syncthreads();
    f32x4 a0 = {0.f, 0.f, 0.f, 0.f}, a1 = a0, a2 = a0, a3 = a0;
    const float* wp = aw + (size_t)(128 * w) * MODW + cg0 + lane;
#pragma unroll 4
    for (int kk = 0; kk < 128; ++kk) {
        const float wv = wp[(size_t)kk * MODW];
        const LAS f32x4* cp = (const LAS f32x4*)(lds + (128 * w + kk) * 16);
        a0 += cp[0] * wv; a1 += cp[1] * wv; a2 += cp[2] * wv; a3 += cp[3] * wv;
    }
    LAS float* red = lds + 16384;
    { LAS float* rp = red + (w * 64 + lane) * 17;
#pragma unroll
      for (int e = 0; e < 4; ++e) { rp[e] = a0[e]; rp[4 + e] = a1[e]; rp[8 + e] = a2[e]; rp[12 + e] = a3[e]; } }
    __syncthreads();
#pragma unroll
    for (int r = 0; r < 2; ++r) { const int o = tid * 2 + r, cl = o >> 4, b = o & 15; float s = 0.f;
#pragma unroll
        for (int ww = 0; ww < 8; ++ww) s += red[(ww * 64 + cl) * 17 + b];
        mod[(size_t)b * MODW + cg0 + cl] = s + ab[cg0 + cl]; }
    __syncthreads();
}
__device__ __forceinline__ void sincos_acc(float ang, float& sn, float& cn) {
    const double a = (double)ang, n = __builtin_rint(a * 0.15915494309189535), r = a - n * 6.283185307179586477, r2 = r * r;
    double ts = r, tc = 1.0, ss = r, sc = 1.0;
#pragma unroll
    for (int k = 0; k < 13; ++k) { tc *= -r2 * (1.0 / (double)((2 * k + 1) * (2 * k + 2))); ts *= -r2 * (1.0 / (double)((2 * k + 2) * (2 * k + 3))); sc += tc; ss += ts; }
    sn = (float)ss; cn = (float)sc;
}
__device__ __forceinline__ void phase0(LAS unsigned char* L, const Params& P) {
    const int tid = tid_opaque(), lane = tid & 63, w = tid >> 6, G = gridDim.x;
    for (int it = blockIdx.x; it < 192; it += G) adaln_item((LAS float*)L, P, it);
    { const int* pos = (const int*)P.in[2]; float* cs = (float*)(P.ws + WS_CS);
      for (int e = blockIdx.x * 512 + tid; e < T * 32; e += G * 512) { const int t = e >> 5, i = e & 31;
          const float inv = (float)exp2(-(double)i * (13.287712379549449 / 32.0)); const float ang = (float)pos[t] * inv; float sn, cn; sincos_acc(ang, sn, cn);
          *(f32x2*)(cs + (size_t)e * 2) = (f32x2){cn, sn}; } }
    LAS float* scr = (LAS float*)L + w * (64 * 33);
    const int gw = blockIdx.x * 8 + w, NGW = G * 8;
    int base = 0;
#pragma unroll
    for (int id = 0; id < N_TRJOBS; ++id) {
        const TrJob J = get_job(P, id); const int nit = (J.K / 64) * (J.Npad / 32);
        int first = (gw - base) % NGW; if (first < 0) first += NGW;
        for (int it = first; it < nit; it += NGW) tr_item(J, scr, it, lane);
        base += nit;
    }
}

__device__ __forceinline__ void rows_modulate(const float* x, const float* sh, const float* sc, bf16_t* u) {
    const int lane = tid_opaque() & 63, gw = blockIdx.x * 8 + (tid_opaque() >> 6), NGW = gridDim.x * 8;
    for (int row = gw; row < T; row += NGW) { const int b = row >> 11;
#pragma unroll
        for (int j = 0; j < 4; ++j) { const int col = 4 * lane + 256 * j; const f32x4 v = *(const f32x4*)(x + (size_t)row * D + col);
            const f32x4 a = *(const f32x4*)(sc + (size_t)b * MODW + col) + 1.0f, s = *(const f32x4*)(sh + (size_t)b * MODW + col);
            *(u32x2*)(u + (size_t)row * D + col) = pack4(v * a + s); } }
}
template <bool FINAL> __device__ __forceinline__ void rows_ln(float* z, float* stats, const float* lng, const float* lnb, const float* sh, const float* sc, bf16_t* u) {
    const int lane = tid_opaque() & 63, gw = blockIdx.x * 8 + (tid_opaque() >> 6), NGW = gridDim.x * 8;
    for (int row = gw; row < T; row += NGW) { const int b = row >> 11;
        f32x4 v[4]; float s = 0.f;
#pragma unroll
        for (int j = 0; j < 4; ++j) { v[j] = *(const f32x4*)(z + (size_t)row * D + 4 * lane + 256 * j); s += (v[j][0] + v[j][1]) + (v[j][2] + v[j][3]); }
        const float mean = wave_sum(s) * (1.f / D); float q = 0.f;
#pragma unroll
        for (int j = 0; j < 4; ++j) { v[j] = v[j] - mean; q += (v[j][0] * v[j][0] + v[j][1] * v[j][1]) + (v[j][2] * v[j][2] + v[j][3] * v[j][3]); }
        const float rstd = 1.f / sqrtf(wave_sum(q) * (1.f / D) + EPS);
        if (!FINAL && lane == 0) *(f32x2*)(stats + (size_t)row * 2) = (f32x2){mean, rstd};
#pragma unroll
        for (int j = 0; j < 4; ++j) { const int col = 4 * lane + 256 * j;
            const f32x4 xn = v[j] * rstd * *(const f32x4*)(lng + col) + *(const f32x4*)(lnb + col);
            if (FINAL) *(f32x4*)(z + (size_t)row * D + col) = xn;
            else { const f32x4 a = *(const f32x4*)(sc + (size_t)b * MODW + col) + 1.0f, sft = *(const f32x4*)(sh + (size_t)b * MODW + col);
                *(u32x2*)(u + (size_t)row * D + col) = pack4(xn * a + sft); } } }
}
__device__ __forceinline__ void phase_cumsum(const float* logf, float* gneg) {
    const int lane = tid_opaque() & 63, gw = blockIdx.x * 8 + (tid_opaque() >> 6), NGW = gridDim.x * 8;
    for (int bh = gw; bh < 256; bh += NGW) { const int b = bh >> 4, h = bh & 15;
        const float* src = logf + ((size_t)b * SEQ + 32 * lane) * 16 + h; float v[32]; float run = 0.f;
#pragma unroll
        for (int i = 0; i < 32; ++i) { run += src[i * 16]; v[i] = run; }
        float incl = run;
#pragma unroll
        for (int o = 1; o < 64; o <<= 1) { const float t = __shfl_up(incl, o); if (lane >= o) incl += t; }
        const float excl = incl - run;
        float* dst = gneg + (size_t)bh * SEQ + 32 * lane;
#pragma unroll
        for (int i = 0; i < 32; i += 4) *(f32x4*)(dst + i) = (f32x4){-(excl + v[i]) * LOG2E, -(excl + v[i + 1]) * LOG2E, -(excl + v[i + 2]) * LOG2E, -(excl + v[i + 3]) * LOG2E}; }
}

template <int DQK, int DV, int NH, bool MLA, bool BIAS>
__device__ __forceinline__ void attn_phase(LAS unsigned char* lds, const bf16_t* __restrict__ Q, const bf16_t* __restrict__ K1, const bf16_t* __restrict__ K2,
                                           const bf16_t* __restrict__ Vt, const float* __restrict__ Gneg, bf16_t* __restrict__ O) {
    constexpr int LDQ = NH * DQK, NKC = DQK / 8, KBYTES = 64 * NKC * 16, VBYTES = DV * 128, BUF = KBYTES + VBYTES + 256;
    constexpr int KCH = 64 * NKC / 512, VCH = DV * 8 / 512, NS = DQK / 16, ND = DV / 32, KHD = MLA ? 128 : 64;
    static_assert(2 * BUF <= 131072, "attention LDS");
    const int tid = tid_opaque(), lane = tid & 63, w = __builtin_amdgcn_readfirstlane(tid >> 6), r32 = lane & 31, hi = lane >> 5;
    const int G = gridDim.x, bx = blockIdx.x, vcu = (G % 8 == 0) ? (bx % 8) * (G / 8) + bx / 8 : bx;
    const int pi = (r32 & ~12) | ((r32 & 4) << 1) | ((r32 & 8) >> 1);
    int koff[KCH]; bool krope[KCH]; int voff[VCH];
#pragma unroll
    for (int i = 0; i < KCH; ++i) { const int c = tid + 512 * i, row = c / NKC, slot = c - row * NKC, q = slot ^ ((row >> 1) & 7);
        krope[i] = MLA && q >= 16; koff[i] = krope[i] ? row * 64 + (q - 16) * 8 : row * 1024 + q * 8; }
#pragma unroll
    for (int i = 0; i < VCH; ++i) { const int c = tid + 512 * i, d = c >> 3, q = (c & 7) ^ ((d >> 1) & 7); voff[i] = d * SEQ + q * 8; }
    int kro[4], vro[4];
    { const int gk = hi ^ ((pi >> 1) & 7), gv = hi ^ ((r32 >> 1) & 7);
#pragma unroll
      for (int j = 0; j < 4; ++j) { kro[j] = pi * NKC * 16 + ((2 * j) ^ gk) * 16; vro[j] = r32 * 128 + ((2 * j) ^ gv) * 16; } }
    constexpr int NPAIRS = NB * NH * 4;
    for (int p = vcu; p < NPAIRS; p += G)
        for (int half = 0; half < 2; ++half) {
            const int bh = p >> 2, sidx = p & 3, qb = half ? 7 - sidx : sidx, b = bh / NH, h = bh - b * NH;
            const int q0 = qb * 256; const size_t rowbase = (size_t)b * SEQ;
            const int NT = 4 * (qb + 1), tl = 4 * qb + (w >> 1);
            bf16x8 qf[NS];
            { const bf16_t* qp = Q + (rowbase + q0 + 32 * w + r32) * LDQ + h * DQK + hi * 8;
#pragma unroll
              for (int s = 0; s < NS; ++s) qf[s] = *(const bf16x8*)(qp + 16 * s); }
            f32x16 o[ND];
#pragma unroll
            for (int d = 0; d < ND; ++d)
#pragma unroll
                for (int r = 0; r < 16; ++r) o[d][r] = 0.f;
            float mrun = -INFINITY, lrun = 0.f;
            f32x4 breg = {0.f, 0.f, 0.f, 0.f};
            const bf16_t* k1b = K1 + rowbase * 1024 + h * KHD; const bf16_t* k2b = MLA ? K2 + rowbase * 64 : K1; const bf16_t* vb = Vt + (size_t)bh * DV * SEQ;
#define ATT_DMA(t, buf) do { \
    _Pragma("unroll") for (int i = 0; i < KCH; ++i) { const bf16_t* src = krope[i] ? k2b + (size_t)(t) * (64 * 64) + koff[i] : k1b + (size_t)(t) * (64 * 1024) + koff[i]; \
        __builtin_amdgcn_global_load_lds((const unsigned*)src, (LAS unsigned*)(lds + (buf) * BUF + (512 * i + 64 * w) * 16), 16, 0, 0); } \
    _Pragma("unroll") for (int i = 0; i < VCH; ++i) \
        __builtin_amdgcn_global_load_lds((const unsigned*)(vb + 64 * (t) + voff[i]), (LAS unsigned*)(lds + (buf) * BUF + KBYTES + (512 * i + 64 * w) * 16), 16, 0, 0); \
    if (BIAS && tid < 16) breg = *(const f32x4*)(Gneg + (size_t)bh * SEQ + 64 * (t) + 4 * tid); } while (0)
#define ATT_BSTORE(buf) do { if (BIAS && tid < 16) *(LAS f32x4*)(lds + (buf) * BUF + KBYTES + VBYTES + 16 * tid) = breg; } while (0)
            ATT_DMA(0, 0); ATT_BSTORE(0); __syncthreads();
            for (int t = 0; t < NT; ++t) {
                const bool more = t + 1 < NT;
                if (more) ATT_DMA(t + 1, (t + 1) & 1);
                if (t <= tl) {
                    const LAS unsigned char* Bc = lds + (t & 1) * BUF;
                    f32x16 pp[2];
#pragma unroll
                    for (int blk = 0; blk < 2; ++blk) {
                        if (BIAS) {
#pragma unroll
                            for (int s2 = 0; s2 < 2; ++s2) { const LAS f32x4* bp = (const LAS f32x4*)(Bc + KBYTES + VBYTES + (32 * blk + 16 * s2 + 8 * hi) * 4); const f32x4 b0 = bp[0], b1 = bp[1];
                                pp[blk][8 * s2 + 0] = b0[0]; pp[blk][8 * s2 + 1] = b0[1]; pp[blk][8 * s2 + 2] = b0[2]; pp[blk][8 * s2 + 3] = b0[3];
                                pp[blk][8 * s2 + 4] = b1[0]; pp[blk][8 * s2 + 5] = b1[1]; pp[blk][8 * s2 + 6] = b1[2]; pp[blk][8 * s2 + 7] = b1[3]; }
                        } else {
#pragma unroll
                            for (int r = 0; r < 16; ++r) pp[blk][r] = 0.f;
                        }
                        const LAS unsigned char* kp = Bc + blk * (32 * NKC * 16);
#pragma unroll
                        for (int s = 0; s < NS; ++s) { const bf16x8 a = *(const LAS bf16x8*)(kp + kro[s & 3] + (s >> 2) * 128); pp[blk] = __builtin_amdgcn_mfma_f32_32x32x16_bf16(a, qf[s], pp[blk], 0, 0, 0);
                            if ((s & 1) == 1) __builtin_amdgcn_sched_barrier(0); }
                    }
                    if (t == tl) {
                        const int qrel = q0 + 32 * w + r32 - 64 * t;
#pragma unroll
                        for (int blk = 0; blk < 2; ++blk)
#pragma unroll
                            for (int r = 0; r < 16; ++r) { const int krel = 32 * blk + 16 * (r >> 3) + 8 * hi + (r & 7); if (krel > qrel) pp[blk][r] = -INFINITY; }
                    }
                    float mx = fmaxf(pp[0][0], pp[1][0]);
#pragma unroll
                    for (int r = 1; r < 16; ++r) mx = fmaxf(mx, fmaxf(pp[0][r], pp[1][r]));
                    mx = fmaxf(mx, __shfl_xor(mx, 32));
                    const float mnew = fmaxf(mrun, mx), alpha = __builtin_amdgcn_exp2f(mrun - mnew); mrun = mnew;
                    float rs = 0.f;
#pragma unroll
                    for (int blk = 0; blk < 2; ++blk)
#pragma unroll
                        for (int r = 0; r < 16; ++r) { const float e = __builtin_amdgcn_exp2f(pp[blk][r] - mnew); pp[blk][r] = e; rs += e; }
                    lrun = lrun * alpha + rs;
#pragma unroll
                    for (int d = 0; d < ND; ++d)
#pragma unroll
                        for (int r = 0; r < 16; ++r) o[d][r] *= alpha;
                    bf16x8 pb[2][2];
#pragma unroll
                    for (int blk = 0; blk < 2; ++blk)
#pragma unroll
                        for (int s2 = 0; s2 < 2; ++s2) { u32x4 wv; wv.x = cvt_pk_bf16(pp[blk][8 * s2 + 0], pp[blk][8 * s2 + 1]); wv.y = cvt_pk_bf16(pp[blk][8 * s2 + 2], pp[blk][8 * s2 + 3]);
                            wv.z = cvt_pk_bf16(pp[blk][8 * s2 + 4], pp[blk][8 * s2 + 5]); wv.w = cvt_pk_bf16(pp[blk][8 * s2 + 6], pp[blk][8 * s2 + 7]); pb[blk][s2] = __builtin_bit_cast(bf16x8, wv); }
                    __builtin_amdgcn_sched_barrier(0);
#pragma unroll
                    for (int d = 0; d < ND; ++d) { const LAS unsigned char* vp = Bc + KBYTES + d * (32 * 128);
#pragma unroll
                        for (int blk = 0; blk < 2; ++blk)
#pragma unroll
                            for (int s2 = 0; s2 < 2; ++s2) { const bf16x8 a = *(const LAS bf16x8*)(vp + vro[2 * blk + s2]); o[d] = __builtin_amdgcn_mfma_f32_32x32x16_bf16(a, pb[blk][s2], o[d], 0, 0, 0); }
                        __builtin_amdgcn_sched_barrier(0); }
                }
                if (more) ATT_BSTORE((t + 1) & 1);
                __syncthreads();
            }
#undef ATT_DMA
#undef ATT_BSTORE
            lrun += __shfl_xor(lrun, 32);
            const float inv = 1.f / lrun;
            bf16_t* op = O + (rowbase + q0 + 32 * w + r32) * 1024 + h * DV + 4 * hi;
#pragma unroll
            for (int d = 0; d < ND; ++d)
#pragma unroll
                for (int g = 0; g < 4; ++g) { const f32x4 v = {o[d][4 * g] * inv, o[d][4 * g + 1] * inv, o[d][4 * g + 2] * inv, o[d][4 * g + 3] * inv};
                    *(u32x2*)(op + 32 * d + 8 * g) = pack4(v); }
        }
}

template <class Epi> __device__ __forceinline__ void run_gemm(LAS unsigned char* L, const bf16_t* A, const bf16_t* Bt, int N, int K, const Epi& E) {
    pg8::Gemm g{A, Bt, T, N, K}; pg8::StaticOrder S; S.init(T, N, (int)gridDim.x, (int)blockIdx.x);
    pg8::gemm_phase<Epi, pg8::StaticOrder, true, true>(L, g, S, E);
}

typedef __attribute__((address_space(4))) const Params CParams;
#define PH_BEGIN CParams* q = Pm; asm volatile("" : "+s"(q)); unsigned char* const ws = q->ws; (void)ws;
#define WSP(T_, off) ((T_*)(ws + (off)))
__global__ void __launch_bounds__(512) mk_fwd(Params P_unused) {
    extern __shared__ __attribute__((aligned(16))) unsigned char lds_raw[];
    LAS unsigned char* L = (LAS unsigned char*)lds_raw;
    cg::grid_group grid = cg::this_grid();
    CParams* Pm = (CParams*)__builtin_amdgcn_kernarg_segment_ptr();
    volatile LAS unsigned* bst = (volatile LAS unsigned*)(L + 131072);
    if (threadIdx.x < 16) bst[threadIdx.x] = 0u;
    __syncthreads();
    XcdBarrier bar;
    { PH_BEGIN; bar = xcd_barrier_post((unsigned*)(ws + WS_BAR), bst); }
    { PH_BEGIN; Params Pl;
#pragma unroll
      for (int i = 0; i < 20; ++i) Pl.in[i] = q->in[i];
      Pl.out = q->out; Pl.ws = ws; phase0(L, Pl); }
    grid.sync();
    { PH_BEGIN; const float* mod0 = WSP(float, WS_MOD); rows_modulate(q->in[0], mod0 + 0 * D, mod0 + 1 * D, WSP(bf16_t, WS_U)); }
    xcd_barrier(bar);
    { PH_BEGIN; EpiMlaIn E{WSP(bf16_t, WS_HQ), WSP(bf16_t, WS_HKV), WSP(bf16_t, WS_KROPE), WSP(float, WS_SSQ), WSP(float, WS_CS)}; run_gemm(L, WSP(bf16_t, WS_U), WSP(bf16_t, WS_WIN0), 768, 1024, E); }
    xcd_barrier(bar);
    { PH_BEGIN; EpiQ E{WSP(bf16_t, WS_Q), WSP(float, WS_SSQ), WSP(float, WS_CS)}; run_gemm(L, WSP(bf16_t, WS_HQ), WSP(bf16_t, WS_WUQ), 1536, 256, E); }
    { PH_BEGIN; EpiKV E{WSP(bf16_t, WS_KNOPE), WSP(bf16_t, WS_VT), WSP(float, WS_SSQ)}; run_gemm(L, WSP(bf16_t, WS_HKV), WSP(bf16_t, WS_WUKV), 2048, 256, E); }
    xcd_barrier(bar);
    { PH_BEGIN; attn_phase<192, 128, 8, true, false>(L, WSP(bf16_t, WS_Q), WSP(bf16_t, WS_KNOPE), WSP(bf16_t, WS_KROPE), WSP(bf16_t, WS_VT), nullptr, WSP(bf16_t, WS_U)); }
    xcd_barrier(bar);
    { PH_BEGIN; EpiRes<true> E{q->in[0], q->out, nullptr, nullptr, nullptr, WSP(float, WS_MOD) + 2 * D}; run_gemm(L, WSP(bf16_t, WS_U), WSP(bf16_t, WS_WO0), 1024, 1024, E); }
    xcd_barrier(bar);
    { PH_BEGIN; const float* mod0 = WSP(float, WS_MOD); rows_ln<false>(q->out, WSP(float, WS_STATS), q->in[18] + 0 * D, q->in[19] + 0 * D, mod0 + 3 * D, mod0 + 4 * D, WSP(bf16_t, WS_U)); }
    xcd_barrier(bar);
    { PH_BEGIN; EpiSwiGLU E{WSP(bf16_t, WS_H)}; run_gemm(L, WSP(bf16_t, WS_U), WSP(bf16_t, WS_WGU0), 2 * FF, 1024, E); }
    xcd_barrier(bar);
    { PH_BEGIN; EpiRes<false> E{nullptr, q->out, WSP(float, WS_STATS), q->in[18] + 0 * D, q->in[19] + 0 * D, WSP(float, WS_MOD) + 5 * D}; run_gemm(L, WSP(bf16_t, WS_H), WSP(bf16_t, WS_WD0), 1024, FF, E); }
    xcd_barrier(bar);
    { PH_BEGIN; const float* mod1 = WSP(float, WS_MOD) + 16 * MODW; rows_ln<false>(q->out, WSP(float, WS_STATS), q->in[18] + 1 * D, q->in[19] + 1 * D, mod1 + 0 * D, mod1 + 1 * D, WSP(bf16_t, WS_U)); }
    xcd_barrier(bar);
    { PH_BEGIN; EpiFoxIn E{WSP(bf16_t, WS_QF), WSP(bf16_t, WS_KF), WSP(bf16_t, WS_VT), WSP(float, WS_LOGF), q->in[11]}; run_gemm(L, WSP(bf16_t, WS_U), WSP(bf16_t, WS_WFIN), 3328, 1024, E); }
    xcd_barrier(bar);
    { PH_BEGIN; phase_cumsum(WSP(float, WS_LOGF), WSP(float, WS_GNEG)); }
    xcd_barrier(bar);
    { PH_BEGIN; attn_phase<64, 64, 16, false, true>(L, WSP(bf16_t, WS_QF), WSP(bf16_t, WS_KF), nullptr, WSP(bf16_t, WS_VT), WSP(float, WS_GNEG), WSP(bf16_t, WS_U)); }
    xcd_barrier(bar);
    { PH_BEGIN; EpiRes<false> E{nullptr, q->out, WSP(float, WS_STATS), q->in[18] + 1 * D, q->in[19] + 1 * D, WSP(float, WS_MOD) + 16 * MODW + 2 * D}; run_gemm(L, WSP(bf16_t, WS_U), WSP(bf16_t, WS_WO1), 1024, 1024, E); }
    xcd_barrier(bar);
    { PH_BEGIN; const float* mod1 = WSP(float, WS_MOD) + 16 * MODW; rows_ln<false>(q->out, WSP(float, WS_STATS), q->in[18] + 2 * D, q->in[19] + 2 * D, mod1 + 3 * D, mod1 + 4 * D, WSP(bf16_t, WS_U)); }
    xcd_barrier(bar);
    { PH_BEGIN; EpiSwiGLU E{WSP(bf16_t, WS_H)}; run_gemm(L, WSP(bf16_t, WS_U), WSP(bf16_t, WS_WGU1), 2 * FF, 1024, E); }
    xcd_barrier(bar);
    { PH_BEGIN; EpiRes<false> E{nullptr, q->out, WSP(float, WS_STATS), q->in[18] + 2 * D, q->in[19] + 2 * D, WSP(float, WS_MOD) + 16 * MODW + 5 * D}; run_gemm(L, WSP(bf16_t, WS_H), WSP(bf16_t, WS_WD1), 1024, FF, E); }
    xcd_barrier(bar);
    { PH_BEGIN; rows_ln<true>(q->out, nullptr, q->in[18] + 3 * D, q->in[19] + 3 * D, nullptr, nullptr, nullptr); }
}

extern "C" void kernel_launch(void* const* d_in, const int* in_sizes, int n_in, void* d_out, int out_size, void* d_ws, size_t ws_size, hipStream_t stream) {
    static int grid = 0;
    if (grid == 0) {
        if (n_in != 20 || out_size != T * D || ws_size < WS_END2) { fprintf(stderr, "kernel_launch: unexpected shapes (n_in %d out %d ws %zu)\n", n_in, out_size, ws_size); grid = -1; return; }
        int dev = 0, cus = 0, per_cu = 0;
        hipGetDevice(&dev); hipDeviceGetAttribute(&cus, hipDeviceAttributeMultiprocessorCount, dev);
        if (hipFuncSetAttribute((const void*)mk_fwd, hipFuncAttributeMaxDynamicSharedMemorySize, LDS_BYTES) != hipSuccess) { fprintf(stderr, "kernel_launch: hipFuncSetAttribute failed\n"); grid = -1; return; }
        hipOccupancyMaxActiveBlocksPerMultiprocessor(&per_cu, (const void*)mk_fwd, 512, LDS_BYTES);
        (void)hipGetLastError();
        if (per_cu < 1) per_cu = 1;
        grid = cus;
    }
    if (grid < 0) return;
    if (hipMemsetAsync((char*)d_ws + WS_BAR, 0, 16384, stream) != hipSuccess) { fprintf(stderr, "kernel_launch: memset failed\n"); return; }
    Params p{};
    for (int i = 0; i < 20; ++i) p.in[i] = (const float*)d_in[i];
    p.out = (float*)d_out; p.ws = (unsigned char*)d_ws;
    void* args[] = {&p};
    hipError_t e = hipLaunchCooperativeKernel((const void*)mk_fwd, dim3(grid), dim3(512), args, LDS_BYTES, stream);
    if (e != hipSuccess) fprintf(stderr, "cooperative launch failed: %s (grid %d)\n", hipGetErrorString(e), grid);
}
```
